# Optimizing an MI355X kernel written in HIP

```python
import math
import jax, jax.numpy as jnp
from jax import lax
import numpy as np


D_MODEL = 1024
BATCH = 32
SEQ = 2048
DEPTH = 1

HEAD_DIM = 64
RWKV_HEADS = 8
RWKV_WIDTH = RWKV_HEADS * HEAD_DIM
DECAY_LORA = 64
ICLR_LORA = 64
GATE_LORA = 128
GROUPNORM_EPS = 64e-5
ATTN_GROUPS = ((128, 1), (512, 4), (2048, 16))
HEADS_PER_GROUP = 4
ATTN_HEADS = HEADS_PER_GROUP * len(ATTN_GROUPS)
ATTN_WIDTH = ATTN_HEADS * HEAD_DIM
ATTN_OUT_WIDTH = HEADS_PER_GROUP * HEAD_DIM
ATTN_BLOCK = 128
N_BUCKETS = 32
MAX_DISTANCE = 2048
N_EXPERTS = 32
TOP_K = 4
D_EXPERT = D_MODEL
SWIGLU_ALPHA = 1.702
SWIGLU_LIMIT = 7.0
MOE_BLOCK = 512
NORM_EPS = 1e-6
NEG_INF = -1e30
IN_SPLITS = (RWKV_WIDTH, 2 * RWKV_WIDTH, 3 * RWKV_WIDTH,
             3 * RWKV_WIDTH + ATTN_WIDTH, 3 * RWKV_WIDTH + 2 * ATTN_WIDTH,
             3 * RWKV_WIDTH + 3 * ATTN_WIDTH, 3 * RWKV_WIDTH + 3 * ATTN_WIDTH + D_MODEL)
IN_COLS = IN_SPLITS[-1] + D_MODEL

kernel_name = 'hybrid_rwkv7_dilated_attn_moe_block'


def rms_norm(x, g):
    xf = x.astype(jnp.float32)
    y = xf * lax.rsqrt(jnp.mean(xf * xf, axis=-1, keepdims=True) + NORM_EPS)
    return (y * g).astype(x.dtype)


def token_shift(x):
    return jnp.pad(x, ((0, 0), (1, 0), (0, 0)))[:, :-1]


def wkv7_scan(r, decay, k, v, a_vec, b_vec):
    Bsz, S, H, N = r.shape
    xs = tuple(t.transpose(1, 0, 2, 3) for t in (r, decay, k, v, a_vec, b_vec))

    def step(state, inp):
        r_t, w_t, k_t, v_t, a_t, b_t = inp
        sa = jnp.einsum('bhvk,bhk->bhv', state, a_t)
        state = (state * w_t[:, :, None, :] + sa[..., None] * b_t[:, :, None, :]
                 + v_t[..., None] * k_t[:, :, None, :])
        return state, jnp.einsum('bhvk,bhk->bhv', state, r_t)

    _, ys = lax.scan(step, jnp.zeros((Bsz, H, N, N), jnp.float32), xs)
    return ys.transpose(1, 0, 2, 3)


def rwkv7_time_mix(h, r, k, v, mu_rkv, mu_wag, w0, w1, w2, a0, a1, a2, g1, g2,
                   k_k, k_a, r_k, ln_w, ln_b):
    Bsz, S, _ = h.shape
    f32 = jnp.float32
    h = h.astype(f32)
    r, k, v = r.astype(f32), k.astype(f32), v.astype(f32)
    dh = token_shift(h) - h
    xw, xa, xg = h + dh * mu_wag[0], h + dh * mu_wag[1], h + dh * mu_wag[2]
    r = r + (token_shift(r) - r) * mu_rkv[0]
    k = k + (token_shift(k) - k) * mu_rkv[1]
    v = v + (token_shift(v) - v) * mu_rkv[2]
    w_log = -jax.nn.softplus(-(w0 + jnp.tanh(xw @ w1) @ w2)) - 0.5
    decay = jnp.exp(-jnp.exp(w_log))
    a = jax.nn.sigmoid(a0 + (xa @ a1) @ a2)
    g = jax.nn.sigmoid(xg @ g1) @ g2
    hs = lambda t: t.reshape(Bsz, S, RWKV_HEADS, HEAD_DIM)
    kk = hs(k * k_k)
    kk = kk / jnp.maximum(jnp.linalg.norm(kk, axis=-1, keepdims=True), 1e-12)
    k = k * (1.0 + (a - 1.0) * k_a)
    rh, kh, vh, ah = hs(r), hs(k), hs(v), hs(a)
    y = wkv7_scan(rh, hs(decay), kh, vh, -kk, kk * ah)
    mu = jnp.mean(y, axis=-1, keepdims=True)
    var = jnp.mean(jnp.square(y - mu), axis=-1, keepdims=True)
    y = ((y - mu) * lax.rsqrt(var + GROUPNORM_EPS)).reshape(Bsz, S, RWKV_WIDTH) * ln_w + ln_b
    bonus = jnp.sum(rh * kh * r_k, axis=-1, keepdims=True) * vh
    y = (y + bonus.reshape(Bsz, S, RWKV_WIDTH)) * g
    return y


def t5_bucket(dist):
    max_exact = N_BUCKETS // 2
    large = max_exact + (jnp.log(jnp.maximum(dist, max_exact).astype(jnp.float32) / max_exact)
                         / math.log(MAX_DISTANCE / max_exact) * (N_BUCKETS - max_exact)).astype(jnp.int32)
    return jnp.where(dist < max_exact, dist, jnp.minimum(large, N_BUCKETS - 1))


def dilated_group_attention(q, k, v, bias_table, window, dilation):
    Bsz, S, H, Dh = q.shape
    L = S // dilation
    nb = -(-L // ATTN_BLOCK)
    Lp = nb * ATTN_BLOCK

    def to_blocks(t):
        t = t.reshape(Bsz, L, dilation, H, Dh).transpose(0, 2, 1, 3, 4)
        t = jnp.pad(t, ((0, 0), (0, 0), (0, Lp - L), (0, 0), (0, 0)))
        return t.reshape(Bsz, dilation, nb, ATTN_BLOCK, H, Dh)

    def with_prev(t):
        prev = jnp.pad(t, ((0, 0), (0, 0), (1, 0), (0, 0), (0, 0), (0, 0)))[:, :, :-1]
        return jnp.concatenate([prev, t], axis=3)

    def from_blocks(t):
        t = t.reshape((Bsz, dilation, Lp) + t.shape[4:])[:, :, :L]
        t = jnp.moveaxis(t, 1, 2)
        return t.reshape((Bsz, S) + t.shape[3:])

    qb = to_blocks(q)
    kw, vw = with_prev(to_blocks(k)), with_prev(to_blocks(v))
    qi = jnp.arange(ATTN_BLOCK)[:, None]
    kj = jnp.arange(2 * ATTN_BLOCK)[None, :]
    steps = qi - kj + ATTN_BLOCK
    bias = jnp.transpose(bias_table[t5_bucket(jnp.maximum(steps, 0) * dilation)], (2, 0, 1))
    band = (steps >= 0) & (steps <= window // dilation)
    valid = band[None] & ((jnp.arange(nb)[:, None, None] > 0) | (kj >= ATTN_BLOCK)[None])
    s = jnp.einsum('bznqhd,bznkhd->bznhqk', qb, kw) + bias.astype(jnp.float32)[None, None, None]
    s = jnp.where(valid[None, None, :, None], s, NEG_INF)
    m = jnp.max(s, axis=-1, keepdims=True)
    p = jnp.exp(s - m)
    den = jnp.sum(p, axis=-1, keepdims=True)
    o = jnp.einsum('bznhqk,bznkhd->bznqhd', p, vw) / jnp.transpose(den, (0, 1, 2, 4, 3, 5))
    lse = jnp.transpose((m + jnp.log(den))[..., 0], (0, 1, 2, 4, 3))
    return from_blocks(o), from_blocks(lse)


def dilated_attention(q, k, v, qn_g, kn_g, rel_bias):
    Bsz, S, _ = q.shape
    hs = lambda t: t.astype(jnp.float32).reshape(Bsz, S, ATTN_HEADS, HEAD_DIM)
    q = rms_norm(hs(q), qn_g) * (HEAD_DIM ** -0.5)
    k = rms_norm(hs(k), kn_g)
    v = hs(v)
    outs, lses = [], []
    for gi, (window, dilation) in enumerate(ATTN_GROUPS):
        sl = slice(gi * HEADS_PER_GROUP, (gi + 1) * HEADS_PER_GROUP)
        o, lse = dilated_group_attention(q[:, :, sl], k[:, :, sl], v[:, :, sl], rel_bias[:, sl],
                                         window, dilation)
        outs.append(o)
        lses.append(lse)
    alpha = jax.nn.softmax(jnp.stack(lses, axis=0), axis=0)
    o = jnp.sum(alpha[..., None] * jnp.stack(outs, axis=0), axis=0)
    return o.reshape(Bsz, S, ATTN_OUT_WIDTH)


def clamped_swiglu(u):
    x_glu, x_lin = u[..., ::2], u[..., 1::2]
    x_glu = jnp.minimum(x_glu, SWIGLU_LIMIT)
    x_lin = jnp.clip(x_lin, -SWIGLU_LIMIT, SWIGLU_LIMIT)
    return x_glu * jax.nn.sigmoid(SWIGLU_ALPHA * x_glu) * (x_lin + 1.0)


def moe_ffn(h, router_w, router_b, w1, b1, w2, b2):
    Bsz, S, D = h.shape
    N = Bsz * S
    hf = h.reshape(N, D)
    logits = (hf @ router_w + router_b).astype(jnp.float32)
    top_v, top_i = lax.top_k(logits, TOP_K)
    gates = jax.nn.softmax(top_v, axis=-1)
    A = N * TOP_K
    flat_e = top_i.reshape(A)
    flat_t = jnp.arange(A, dtype=jnp.int32) // TOP_K
    flat_g = gates.reshape(A)
    order = jnp.argsort(flat_e)
    se, st, sg = flat_e[order], flat_t[order], flat_g[order]
    counts = jnp.bincount(flat_e, length=N_EXPERTS)
    padded = (counts + MOE_BLOCK - 1) // MOE_BLOCK * MOE_BLOCK
    start = jnp.cumsum(counts) - counts
    pend = jnp.cumsum(padded)
    pstart = pend - padded
    dest = pstart[se] + jnp.arange(A, dtype=jnp.int32) - start[se]
    n_blocks = -(-A // MOE_BLOCK) + N_EXPERTS
    rows = n_blocks * MOE_BLOCK
    tok_buf = jnp.zeros((rows,), jnp.int32).at[dest].set(st)
    gate_buf = jnp.zeros((rows,), jnp.float32).at[dest].set(sg)
    blk_e = jnp.minimum(jnp.searchsorted(pend, jnp.arange(n_blocks, dtype=jnp.int32) * MOE_BLOCK,
                                         side='right'), N_EXPERTS - 1)

    def block(acc, inp):
        tok, g, e = inp
        u = hf[tok] @ w1[e] + b1[e]
        o = clamped_swiglu(u) @ w2[e] + b2[e]
        return acc.at[tok].add(o.astype(jnp.float32) * g[:, None]), None

    acc, _ = lax.scan(block, jnp.zeros((N, D), jnp.float32),
                      (tok_buf.reshape(n_blocks, MOE_BLOCK), gate_buf.reshape(n_blocks, MOE_BLOCK), blk_e))
    return acc.reshape(Bsz, S, D).astype(h.dtype)


def hybrid_layer(x, c, ada_w, ada_b, norm1_g, norm2_g, w_in, rwkv_mu_rkv, rwkv_mu_wag,
                 rwkv_w0, rwkv_w1, rwkv_w2, rwkv_a0, rwkv_a1, rwkv_a2, rwkv_g1, rwkv_g2,
                 rwkv_k_k, rwkv_k_a, rwkv_r_k, rwkv_ln_w, rwkv_ln_b, attn_qn_g, attn_kn_g,
                 rel_bias, w_br_rwkv, w_br_attn, w_out, router_w, router_b,
                 exp_w1, exp_b1, exp_w2, exp_b2):
    mod = jax.nn.silu(c) @ ada_w + ada_b
    shift1, scale1, gate1, shift2, scale2, gate2 = [m[:, None, :] for m in jnp.split(mod, 6, axis=-1)]
    h = rms_norm(x, norm1_g) * (1.0 + scale1) + shift1
    proj = h @ w_in
    r, k, v, qa, ka, va, gr, ga = jnp.split(proj, IN_SPLITS, axis=-1)
    y_rwkv = rwkv7_time_mix(h, r, k, v, rwkv_mu_rkv, rwkv_mu_wag, rwkv_w0, rwkv_w1, rwkv_w2,
                            rwkv_a0, rwkv_a1, rwkv_a2, rwkv_g1, rwkv_g2, rwkv_k_k, rwkv_k_a,
                            rwkv_r_k, rwkv_ln_w, rwkv_ln_b).astype(x.dtype) @ w_br_rwkv
    y_attn = dilated_attention(qa, ka, va, attn_qn_g, attn_kn_g, rel_bias).astype(x.dtype) @ w_br_attn
    mixed = jax.nn.sigmoid(gr) * y_rwkv + jax.nn.sigmoid(ga) * y_attn
    x = x + gate1 * (mixed @ w_out)
    h2 = rms_norm(x, norm2_g) * (1.0 + scale2) + shift2
    x = x + gate2 * moe_ffn(h2, router_w, router_b, exp_w1, exp_b1, exp_w2, exp_b2)
    return x


def setup_inputs(seed: int = 0) -> dict:
    key = jax.random.key(seed)
    ks = iter(jax.random.split(key, 40))
    f32 = jnp.float32
    nrm = lambda shape, scale: jax.random.normal(next(ks), shape, f32) * scale
    uni = lambda shape, lo, hi: jax.random.uniform(next(ks), shape, f32, lo, hi)
    L, D, RW = DEPTH, D_MODEL, RWKV_WIDTH
    return {
        'x': nrm((BATCH, SEQ, D), 1.0),
        'c': nrm((BATCH, D), 1.0),
        'ada_w': nrm((L, D, 6 * D), D ** -0.5),
        'ada_b': nrm((L, 6 * D), 0.02),
        'norm1_g': 1.0 + nrm((L, D), 0.02),
        'norm2_g': 1.0 + nrm((L, D), 0.02),
        'w_in': nrm((L, D, IN_COLS), D ** -0.5),
        'rwkv_mu_rkv': uni((L, 3, RW), 0.0, 1.0),
        'rwkv_mu_wag': uni((L, 3, D), 0.0, 1.0),
        'rwkv_w0': uni((L, RW), -6.0, 1.0),
        'rwkv_w1': nrm((L, D, DECAY_LORA), D ** -0.5),
        'rwkv_w2': nrm((L, DECAY_LORA, RW), DECAY_LORA ** -0.5),
        'rwkv_a0': nrm((L, RW), 0.1),
        'rwkv_a1': nrm((L, D, ICLR_LORA), D ** -0.5),
        'rwkv_a2': nrm((L, ICLR_LORA, RW), ICLR_LORA ** -0.5),
        'rwkv_g1': nrm((L, D, GATE_LORA), D ** -0.5),
        'rwkv_g2': nrm((L, GATE_LORA, RW), GATE_LORA ** -0.5),
        'rwkv_k_k': 0.85 + nrm((L, RW), 0.02),
        'rwkv_k_a': 1.0 + nrm((L, RW), 0.02),
        'rwkv_r_k': nrm((L, RWKV_HEADS, HEAD_DIM), 0.1),
        'rwkv_ln_w': 1.0 + nrm((L, RW), 0.02),
        'rwkv_ln_b': nrm((L, RW), 0.02),
        'attn_qn_g': 1.0 + nrm((L, HEAD_DIM), 0.02),
        'attn_kn_g': 1.0 + nrm((L, HEAD_DIM), 0.02),
        'rel_bias': nrm((N_BUCKETS, ATTN_HEADS), 0.5),
        'w_br_rwkv': nrm((L, RW, D), RW ** -0.5),
        'w_br_attn': nrm((L, ATTN_OUT_WIDTH, D), ATTN_OUT_WIDTH ** -0.5),
        'w_out': nrm((L, D, D), D ** -0.5),
        'router_w': nrm((L, D, N_EXPERTS), D ** -0.5),
        'router_b': nrm((L, N_EXPERTS), 0.01),
        'exp_w1': nrm((L, N_EXPERTS, D, 2 * D_EXPERT), D ** -0.5),
        'exp_b1': nrm((L, N_EXPERTS, 2 * D_EXPERT), 0.02),
        'exp_w2': nrm((L, N_EXPERTS, D_EXPERT, D), D_EXPERT ** -0.5),
        'exp_b2': nrm((L, N_EXPERTS, D), 0.02),
    }


def reference(x, c, ada_w, ada_b, norm1_g, norm2_g, w_in, rwkv_mu_rkv, rwkv_mu_wag,
              rwkv_w0, rwkv_w1, rwkv_w2, rwkv_a0, rwkv_a1, rwkv_a2, rwkv_g1, rwkv_g2,
              rwkv_k_k, rwkv_k_a, rwkv_r_k, rwkv_ln_w, rwkv_ln_b, attn_qn_g, attn_kn_g,
              rel_bias, w_br_rwkv, w_br_attn, w_out, router_w, router_b,
              exp_w1, exp_b1, exp_w2, exp_b2):
    for l in range(DEPTH):
        x = hybrid_layer(x, c, ada_w[l], ada_b[l], norm1_g[l], norm2_g[l], w_in[l],
                         rwkv_mu_rkv[l], rwkv_mu_wag[l], rwkv_w0[l], rwkv_w1[l], rwkv_w2[l],
                         rwkv_a0[l], rwkv_a1[l], rwkv_a2[l], rwkv_g1[l], rwkv_g2[l],
                         rwkv_k_k[l], rwkv_k_a[l], rwkv_r_k[l], rwkv_ln_w[l], rwkv_ln_b[l],
                         attn_qn_g[l], attn_kn_g[l], rel_bias, w_br_rwkv[l], w_br_attn[l],
                         w_out[l], router_w[l], router_b[l], exp_w1[l], exp_b1[l],
                         exp_w2[l], exp_b2[l])
    return x
```

```cpp
#include <hip/hip_runtime.h>
#include <cstdio>
#include <cstdint>

#ifndef MK_N_LAUNCHES
#define MK_N_LAUNCHES 1
#endif

#ifndef PROBE_DUP
#define PROBE_DUP 0u
#endif
#define NREP(k) ((((PROBE_DUP) >> (k)) & 1u) ? 2 : 1)
#define GAS __attribute__((address_space(1)))
#define LAS __attribute__((address_space(3)))
typedef unsigned short bf16;
typedef unsigned v4u __attribute__((ext_vector_type(4)));
typedef unsigned v2u __attribute__((ext_vector_type(2)));
typedef float f32x2 __attribute__((ext_vector_type(2)));
typedef float f32x4 __attribute__((ext_vector_type(4)));
typedef float f32x16 __attribute__((ext_vector_type(16)));
typedef short bf16x8 __attribute__((ext_vector_type(8)));
typedef short v4i16_t __attribute__((ext_vector_type(4)));
typedef int v8i_t __attribute__((ext_vector_type(8)));

constexpr int BATCH = 32, SEQ = 2048, D = 1024, NTOK = BATCH * SEQ;
constexpr int RW = 512, HD = 64, NEXP = 32, TOPK = 4;
constexpr int NEXT = 6400;
constexpr int C_RKV = 1536, C_ATT = 2304, C_GATE = 2048, C_LORA = 512, C_YC = 768;
constexpr int CAP = NTOK;
constexpr int MOE_ROWS = NTOK * TOPK + NEXP * 256;

constexpr size_t MiB = 1u << 20;
constexpr size_t WS_CTL = 0, CTL_ZERO_BYTES = 64 * 1024;
constexpr size_t WS_MOD = 1 * MiB;
constexpr size_t WS_LUT = WS_MOD + 768 * 1024;
constexpr size_t WS_B1P = WS_LUT + 8 * 1024;
constexpr size_t WS_WEXT = 2 * MiB + 512 * 1024;
constexpr size_t WS_WBRR = 15 * MiB;
constexpr size_t WS_WBRA = 16 * MiB;
constexpr size_t WS_WOUT = 16 * MiB + 512 * 1024;
constexpr size_t WS_W2T = 18 * MiB + 512 * 1024;
constexpr size_t WS_A2T = WS_W2T + 64 * 1024, WS_G2T = WS_A2T + 64 * 1024;
constexpr size_t WS_GATES = 19 * MiB;
constexpr size_t WS_TSLOT = 20 * MiB;
constexpr size_t WS_LIST = 21 * MiB;
constexpr size_t WS_LSE = 29 * MiB;
constexpr size_t WS_W1T = 32 * MiB;
constexpr size_t WS_W2E = 160 * MiB;
constexpr size_t WS_PRKV = 224 * MiB;
constexpr size_t WS_PGATE = 416 * MiB;
constexpr size_t WS_PATT = 672 * MiB;
constexpr size_t WS_MIXED = WS_PRKV;
constexpr size_t WS_ACT = 224 * MiB;
constexpr size_t WS_OBUF = 488 * MiB;
constexpr size_t WS_H2 = 896 * MiB;
constexpr size_t WS_X1 = 752 * MiB;
constexpr size_t WS_END = 1024 * MiB;
constexpr size_t DO_H = 0, DO_YR = 0, DO_YA = 64 * MiB, DO_PLORA = 128 * MiB;

constexpr int CW_BAR = 1024;
constexpr int CW_CNT = 8192;

constexpr int LDS_BYTES = 160 * 1024;
constexpr int MISC_OFF = LDS_BYTES - 512;
constexpr int RING_BYTES = 131072;

#define LDS_WAIT() asm volatile("s_waitcnt lgkmcnt(0)" ::: "memory")
#define VM_WAIT() asm volatile("s_waitcnt vmcnt(0)" ::: "memory")
typedef __bf16 bf16x2_t __attribute__((ext_vector_type(2)));
__device__ __forceinline__ unsigned cvt_pk_bf16(float lo, float hi) { const f32x2 v = {lo, hi}; const bf16x2_t b = __builtin_convertvector(v, bf16x2_t); return __builtin_bit_cast(unsigned, b); }
__device__ __forceinline__ unsigned pk4_fp8(float a, float b, float c, float d) { int w = __builtin_amdgcn_cvt_pk_fp8_f32(a, b, 0, false); w = __builtin_amdgcn_cvt_pk_fp8_f32(c, d, w, true); return (unsigned)w; }
__device__ __forceinline__ v4u quad_transpose(unsigned a0, unsigned a1, unsigned a2, unsigned a3, int lane) {
    const bool odd = (lane & 1) != 0, hi = (lane & 2) != 0;
    const unsigned s0 = odd ? a0 : a1, s1 = odd ? a2 : a3;
    const unsigned r0 = (unsigned)__builtin_amdgcn_mov_dpp((int)s0, 0xB1, 0xF, 0xF, true), r1 = (unsigned)__builtin_amdgcn_mov_dpp((int)s1, 0xB1, 0xF, 0xF, true);
    const unsigned c0 = odd ? r0 : a0, c1 = odd ? a1 : r0, c2 = odd ? r1 : a2, c3 = odd ? a3 : r1;
    const unsigned t0 = hi ? c0 : c2, t1 = hi ? c1 : c3;
    const unsigned q0 = (unsigned)__builtin_amdgcn_mov_dpp((int)t0, 0x4E, 0xF, 0xF, true), q1 = (unsigned)__builtin_amdgcn_mov_dpp((int)t1, 0x4E, 0xF, 0xF, true);
    return (v4u){hi ? q0 : c0, hi ? q1 : c1, hi ? c2 : q0, hi ? c3 : q1};
}
__device__ __forceinline__ float bf_lo(unsigned u) { return __uint_as_float(u << 16); }
__device__ __forceinline__ float bf_hi(unsigned u) { return __uint_as_float(u & 0xffff0000u); }
__device__ __forceinline__ float sigmoidf_(float x) { return __builtin_amdgcn_rcpf(1.0f + __expf(-x)); }
template <int CTRL> __device__ __forceinline__ float dpp_f(float v) { return __int_as_float(__builtin_amdgcn_update_dpp(0, __float_as_int(v), CTRL, 0xf, 0xf, true)); }
__device__ __forceinline__ float reduce8(float v) { v += dpp_f<0xB1>(v); v += dpp_f<0x4E>(v); v += dpp_f<0x141>(v); return v; }
__device__ __forceinline__ float reduce16(float v) { v = reduce8(v); v += dpp_f<0x140>(v); return v; }
__device__ __forceinline__ float wave_sum(float v) {
#pragma unroll
    for (int o = 1; o < 64; o <<= 1) v += __shfl_xor(v, o);
    return v;
}
__device__ __forceinline__ int crow(int r, int hi) { return (r & 3) + 8 * (r >> 2) + 4 * hi; }

#define XB_TMO      128
#define XB_XCNT(j)  (256  + 64 * (j))
#define XB_XSUB(j)  (1280 + 64 * (j))
#define XB_XGEN(j)  (2304 + 64 * (j))
#define XB_TOP      3328
#define XB_TOPGEN   3392
#define XCD_BAR_WORDS 3456
#define XB_SPIN_CAP (1u << 18)
__device__ __forceinline__ unsigned xb_ld(unsigned* p)              { return __hip_atomic_load(p, __ATOMIC_RELAXED, __HIP_MEMORY_SCOPE_AGENT); }
__device__ __forceinline__ unsigned xb_add(unsigned* p, unsigned v) { return __hip_atomic_fetch_add(p, v, __ATOMIC_RELAXED, __HIP_MEMORY_SCOPE_AGENT); }
__device__ __forceinline__ unsigned xb_xcc_id() { return (unsigned)__builtin_amdgcn_s_getreg((3 << 11) | 20) & 0xFu; }
#define XB_SPIN(cond, bar) do { unsigned _sp = 0; while (cond) { __builtin_amdgcn_s_sleep(1); \
    if ((++_sp & 255u) == 0u) { if (xb_ld(&(bar)[XB_TMO])) break; if (_sp > XB_SPIN_CAP) { atomicAdd(&(bar)[XB_TMO], 1u); break; } } } } while (0)
struct XcdBarrier { unsigned* bar; unsigned x; volatile LAS unsigned* st; };
__device__ __forceinline__ XcdBarrier xcd_barrier_post(unsigned* bar, volatile LAS unsigned* st) {
    XcdBarrier b; b.bar = bar; b.x = xb_xcc_id(); b.st = st;
    if (threadIdx.x == 0) (void)xb_add(&bar[XB_XCNT(b.x)], 1u);
    return b;
}
__device__ __forceinline__ void xcd_barrier_complete(unsigned* bar, unsigned x, unsigned& nloc, unsigned& nx) {
    const unsigned G = gridDim.x * gridDim.y * gridDim.z;
    unsigned sum, cnt, mine, sp = 0u;
    for (;;) {
        sum = 0u; cnt = 0u; mine = 0u;
#pragma unroll
        for (unsigned j = 0; j < 16; ++j) { const unsigned c = xb_ld(&bar[XB_XCNT(j)]); sum += c; cnt += (c > 0u) ? 1u : 0u; mine = (j == x) ? c : mine; }
        if (sum == G) break;
        __builtin_amdgcn_s_sleep(1);
        if ((++sp & 255u) == 0u) { if (xb_ld(&bar[XB_TMO])) break; if (sp > XB_SPIN_CAP) { atomicAdd(&bar[XB_TMO], 1u); break; } }
    }
    nloc = mine > 0u ? mine : 1u; nx = cnt > 0u ? cnt : 1u;
}
__device__ __forceinline__ void xcd_barrier(const XcdBarrier& b) {
    asm volatile("s_waitcnt vmcnt(0)" ::: "memory");
    __syncthreads();
    if (threadIdx.x == 0) {
        unsigned* bar = b.bar;
        __builtin_amdgcn_s_waitcnt(0);
        unsigned nloc = b.st[0], nx = b.st[1];
        if (nloc == 0u) { xcd_barrier_complete(bar, b.x, nloc, nx); b.st[0] = nloc; b.st[1] = nx; }
        const unsigned old = xb_add(&bar[XB_XSUB(b.x)], 1u);
        const unsigned gen = old / nloc;
        if (old + 1u == (gen + 1u) * nloc) {
            __builtin_amdgcn_fence(__ATOMIC_RELEASE, "agent");
            asm volatile("s_waitcnt vmcnt(0)" ::: "memory");
            const unsigned og = xb_add(&bar[XB_TOP], 1u);
            const unsigned tg = og / nx;
            if (og + 1u == (tg + 1u) * nx) xb_add(&bar[XB_TOPGEN], 1u);
            else XB_SPIN(xb_ld(&bar[XB_TOPGEN]) == tg, bar);
            __builtin_amdgcn_fence(__ATOMIC_ACQUIRE, "agent");
            xb_add(&bar[XB_XGEN(b.x)], 1u);
            asm volatile("s_waitcnt vmcnt(0)" ::: "memory");
        } else {
            XB_SPIN(xb_ld(&bar[XB_XGEN(b.x)]) == gen, bar);
            __builtin_amdgcn_fence(__ATOMIC_ACQUIRE, "agent");
            asm volatile("s_waitcnt vmcnt(0)" ::: "memory");
        }
    }
    __syncthreads();
}

namespace pg8 {
constexpr int BM = 256, BK = 64, HALF = 128, HTB = HALF * BK * 2, NXCD = 8;
__host__ __device__ __forceinline__ int lds_byte(int r, int c) { const int st = (r >> 4) * 2 + (c >> 5), rr = r & 15, cc = c & 31, ob = rr * 64 + cc * 2; return st * 1024 + (ob ^ (((ob >> 9) & 1) << 5)); }
__host__ __device__ __forceinline__ void stage_rc(int b, int& R, int& C) { const int st = b / 1024, sb = b % 1024, swz = sb ^ (((sb >> 9) & 1) << 5); R = (st >> 1) * 16 + swz / 64; C = (st & 1) * 32 + (swz % 64) / 2; }
__host__ __device__ __forceinline__ int perm32(int rho) { const int n = rho >> 4, i = rho & 15; return 8 * (i >> 2) + 4 * n + (i & 3); }

struct Unit { int pm, pn, e, aux; };

struct DenseOrder {
    static constexpr bool SEG = false;
    const char* A; const char* Bt; int K, rb, nM, nN, nwg, G, c;
    __device__ __forceinline__ void init(const void* A_, const void* Bt_, int M, int N, int K_, int G_, int c_) { A = (const char*)A_; Bt = (const char*)Bt_; K = K_; rb = K_ * 2; nM = M / BM; nN = N / BM; nwg = nM * nN; G = G_; c = c_; }
    __device__ __forceinline__ bool next(int i, Unit& u) const {
        const long L = (long)i * G + c; if (L >= nwg) return false;
        int wgid = (int)L; { const int q = nwg / NXCD, r = nwg % NXCD, xcd = wgid % NXCD, off = wgid / NXCD; wgid = (xcd < r ? xcd * (q + 1) : r * (q + 1) + (xcd - r) * q) + off; }
        const int nig = 8 * nN, gid = wgid / nig, fm = gid * 8, gsz = (nM - fm) < 8 ? (nM - fm) : 8;
        u.pm = fm + ((wgid % nig) % gsz); u.pn = (wgid % nig) / gsz; u.e = 0; u.aux = 256; return true;
    }
    __device__ __forceinline__ unsigned A0(const Unit& u) const { return (unsigned)u.pm * 256u * (unsigned)rb; }
    __device__ __forceinline__ unsigned B0(const Unit& u) const { return (unsigned)u.pn * 256u * (unsigned)rb; }
    __device__ __forceinline__ const int* rows(const Unit&) const { return nullptr; }
    __device__ __forceinline__ const int* rows_base() const { return nullptr; }
    __device__ __forceinline__ unsigned rows_off(const Unit&) const { return 0u; }
};
struct SegOrder {
    static constexpr bool SEG = true;
    const char* A; const char* Bt; int rb, nM, nN, nwg, G, c;
    __device__ __forceinline__ void init(const void* A_, const void* Bt_, int M, int N, int G_, int c_) { A = (const char*)A_; Bt = (const char*)Bt_; rb = 768 * 2; nM = M / BM; nN = N / BM; nwg = nM * nN; G = G_; c = c_; }
    __device__ __forceinline__ bool next(int i, Unit& u) const {
        const long L = (long)(i >> 1) * G + c; if (L >= nwg) return false;
        int wgid = (int)L; { const int q = nwg / NXCD, r = nwg % NXCD, xcd = wgid % NXCD, off = wgid / NXCD; wgid = (xcd < r ? xcd * (q + 1) : r * (q + 1) + (xcd - r) * q) + off; }
        const int nig = 8 * nN, gid = wgid / nig, fm = gid * 8, gsz = (nM - fm) < 8 ? (nM - fm) : 8;
        u.pm = fm + ((wgid % nig) % gsz); u.pn = (wgid % nig) / gsz; u.e = i & 1; u.aux = 256; return true;
    }
    __device__ __forceinline__ int nt_of(const Unit& u) const { return u.e ? 4 : 8; }
    __device__ __forceinline__ unsigned A0(const Unit& u) const { return (unsigned)u.pm * 256u * (unsigned)rb + (u.e ? 1024u : 0u); }
    __device__ __forceinline__ unsigned B0(const Unit& u) const { return (unsigned)u.pn * 256u * (unsigned)rb + (u.e ? 1024u : 0u); }
    __device__ __forceinline__ const int* rows(const Unit&) const { return nullptr; }
    __device__ __forceinline__ const int* rows_base() const { return nullptr; }
    __device__ __forceinline__ unsigned rows_off(const Unit&) const { return 0u; }
};
struct MoeOrder {
    static constexpr bool SEG = false;
    const char* A; const char* Bt; int K, rb, ncol, nunits, G, c; size_t bstride;
    const LAS int* tpre;
    const LAS int* cnt;
    const int* list;
    __device__ __forceinline__ bool next(int i, Unit& u) const {
        const long L = (long)i * G + c; if (L >= nunits) return false;
        int wgid = (int)L; { const int q = nunits / NXCD, r = nunits % NXCD, xcd = wgid % NXCD, off = wgid / NXCD; wgid = (xcd < r ? xcd * (q + 1) : r * (q + 1) + (xcd - r) * q) + off; }
        const int gt = wgid / ncol;
        int e = 0;
#pragma unroll 1
        for (int s = 16; s >= 1; s >>= 1) { if (tpre[e + s] * ncol <= wgid) e += s; }
        (void)gt;
        const int ul = wgid - tpre[e] * ncol, nt = tpre[e + 1] - tpre[e];
        const int nig = 4 * ncol, gid = ul / nig, fm = gid * 4, gsz = (nt - fm) < 4 ? (nt - fm) : 4;
        const int rt = fm + ((ul % nig) % gsz);
        u.pn = __builtin_amdgcn_readfirstlane((ul % nig) / gsz); u.e = __builtin_amdgcn_readfirstlane(e); u.pm = __builtin_amdgcn_readfirstlane(tpre[e] + rt);
        const int left = cnt[e] - rt * 256; u.aux = __builtin_amdgcn_readfirstlane(left < 256 ? left : 256);
        return true;
    }
    __device__ __forceinline__ unsigned A0(const Unit& u) const { return (unsigned)u.pm * 256u * (unsigned)rb; }
    __device__ __forceinline__ unsigned B0(const Unit& u) const { return (unsigned)u.e * (unsigned)bstride + (unsigned)u.pn * 256u * (unsigned)rb; }
    __device__ __forceinline__ const int* rows(const Unit& u) const { return list + (size_t)u.e * CAP + (size_t)(u.pm - tpre[u.e]) * 256; }
    __device__ __forceinline__ const int* rows_base() const { return list; }
    __device__ __forceinline__ unsigned rows_off(const Unit& u) const { return (unsigned)__builtin_amdgcn_readfirstlane((u.e * CAP + (u.pm - tpre[u.e]) * 256) * 4); }
};

__device__ __forceinline__ void mfma_fp8_acc(f32x4& c, const v8i_t a, const v8i_t b, const int sa, const int sb) {
    asm volatile("v_mfma_scale_f32_16x16x128_f8f6f4 %0, %1, %2, %0, %3, %4 op_sel_hi:[0,0,0]" : "+v"(c) : "v"(a), "v"(b), "v"(sa), "v"(sb));
}
__device__ __forceinline__ void mfma_bf16_acc(f32x4& c, const bf16x8 a, const bf16x8 b) {
    asm volatile("v_mfma_f32_16x16x32_bf16 %0, %1, %2, %0" : "+v"(c) : "v"(a), "v"(b));
}
#define PG8_MFMA_DRAIN() asm volatile("s_nop 15\n\ts_nop 15" : "+v"(acc[1][1][3][1]), "+v"(acc[1][1][3][0]), "+v"(acc[1][1][2][1]), "+v"(acc[1][1][2][0]) :: "memory")
template <class Epi, class Sched, bool GATHER, bool FP8 = false>
__device__ __forceinline__ void gemm_phase(LAS unsigned char* lds, const Sched& S, const Epi& E) {
    const int tid = threadIdx.x, wid = __builtin_amdgcn_readfirstlane(tid >> 6), lane = tid & 63, wr = wid >> 2, wc = wid & 3, fr = lane & 15, fq = lane >> 4;
    const int RBy = S.rb; int nt = RBy / 128;
    const __amdgpu_buffer_rsrc_t rsA = __builtin_amdgcn_make_buffer_rsrc((void*)S.A, 0, 0x7fffffff, 0x00020000);
    const __amdgpu_buffer_rsrc_t rsB = __builtin_amdgcn_make_buffer_rsrc((void*)S.Bt, 0, 0x7fffffff, 0x00020000);
    constexpr bool AUX = Epi::AUX;
    constexpr int AUX_IDS = RING_BYTES + 1024, AUX_BIAS = RING_BYTES + 3072;
    const void* lbase_ = S.A; const void* bbase_ = S.A;
    if constexpr (AUX) { lbase_ = S.rows_base(); bbase_ = E.bias_base(); }
    const __amdgpu_buffer_rsrc_t rsL = __builtin_amdgcn_make_buffer_rsrc((void*)lbase_, 0, 0x7fffffff, 0x00020000);
    const __amdgpu_buffer_rsrc_t rsBi = __builtin_amdgcn_make_buffer_rsrc((void*)bbase_, 0, 0x7fffffff, 0x00020000);
    int voffB[2], voffA0[2], voffA1[2];
#pragma unroll
    for (int i = 0; i < 2; ++i) { int R, C; stage_rc(tid * 16 + i * 8192, R, C); const int Rb = Epi::PERM ? ((R & ~31) + perm32(R & 31)) : R;
        voffA0[i] = R * RBy + C * 2; voffA1[i] = voffA0[i]; voffB[i] = Rb * RBy + C * 2; }
    const unsigned kstep = 128u;
    const unsigned hstep = (unsigned)HALF * (unsigned)RBy;
    const unsigned ahstep = GATHER ? 0u : hstep;
    const unsigned ldsw = (unsigned)wid * 1024u;
    const int aoff = lds_byte(wr * 64 + fr, fq * 8), boff = lds_byte(wc * 32 + fr, fq * 8);
#define PG8_SA(b, h) (((b) * 2 + (h)) * HTB)
#define PG8_SB(b, h) ((4 + (b) * 2 + (h)) * HTB)
#define PG8_STAGE(rs, bufoff, soff, voff) do { _Pragma("unroll") for (int _i = 0; _i < 2; ++_i) \
        __builtin_amdgcn_raw_ptr_buffer_load_lds(rs, (LAS void*)(lds + (bufoff) + ldsw + _i * 8192), 16, (voff)[_i], (int)(soff), 0, 0); } while (0)
#define PG8_LDA(dst, b, h) do { _Pragma("unroll") for (int m = 0; m < 4; ++m) _Pragma("unroll") for (int k = 0; k < 2; ++k) dst[m][k] = *(const LAS bf16x8*)(lds + PG8_SA(b, h) + aoff + m * 2048 + k * 1024); } while (0)
#define PG8_LDB(dst, b, h) do { _Pragma("unroll") for (int n = 0; n < 2; ++n) _Pragma("unroll") for (int k = 0; k < 2; ++k) dst[n][k] = *(const LAS bf16x8*)(lds + PG8_SB(b, h) + boff + n * 2048 + k * 1024); } while (0)
#define PG8_CAT(x) __builtin_bit_cast(v8i_t, __builtin_shufflevector(x[0], x[1], 0, 1, 2, 3, 4, 5, 6, 7, 8, 9, 10, 11, 12, 13, 14, 15))
#define PG8_MMA(ai, bj, At, Bt) do { __builtin_amdgcn_s_setprio(1); \
        if constexpr (FP8) { _Pragma("unroll") for (int m = 0; m < 4; ++m) _Pragma("unroll") for (int n = 0; n < 2; ++n) \
            mfma_fp8_acc(acc[ai][bj][m][n], PG8_CAT(Bt[n]), PG8_CAT(At[m]), sclW, sclA); } \
        else if constexpr (true) { _Pragma("unroll") for (int k = 0; k < 2; ++k) _Pragma("unroll") for (int m = 0; m < 4; ++m) _Pragma("unroll") for (int n = 0; n < 2; ++n) \
            mfma_bf16_acc(acc[ai][bj][m][n], Bt[n][k], At[m][k]); }        \
        else { _Pragma("unroll") for (int m = 0; m < 4; ++m) _Pragma("unroll") for (int n = 0; n < 2; ++n) _Pragma("unroll") for (int k = 0; k < 2; ++k) \
            acc[ai][bj][m][n] = __builtin_amdgcn_mfma_f32_16x16x32_bf16(Bt[n][k], At[m][k], acc[ai][bj][m][n], 0, 0, 0); } \
        __builtin_amdgcn_s_setprio(0); } while (0)
#define PG8_WAIT_V(n) asm volatile("s_waitcnt vmcnt(" #n ")" ::: "memory")
#define PG8_WAIT_VX() asm volatile("s_waitcnt vmcnt(%0)" :: "i"((8 + Epi::NVM) > 63 ? 63 : (8 + Epi::NVM)) : "memory")
#define PG8_WAIT_L(n) asm volatile("s_waitcnt lgkmcnt(" #n ")" ::: "memory")
#define PG8_BAR __builtin_amdgcn_s_barrier()
#define PG8_SCHED __builtin_amdgcn_sched_barrier(0)
#define PG8_TRIP(WAITX) do { \
            const bool last = (t == nt - 2); \
            const unsigned a1 = cA + (unsigned)(t + 1) * kstep; \
            const unsigned a2 = last ? nA : cA + (unsigned)(t + 2) * kstep, b2 = last ? nB : cB + (unsigned)(t + 2) * kstep; \
            const unsigned a3 = a2 + kstep, b3 = b2 + kstep; \
            int nx0[2] = {0, 0}, nx1[2] = {0, 0}; \
            if constexpr (AUX) { if (t == nt - 4 && has_next) { const int sl_ = ((ui + 1) & 1) * 1024; \
                if constexpr (GATHER) __builtin_amdgcn_raw_ptr_buffer_load_lds(rsL, (LAS void*)(lds + AUX_IDS + sl_), 16, lane * 16, (int)S.rows_off(nxt), 0, 0); \
                __builtin_amdgcn_raw_ptr_buffer_load_lds(rsBi, (LAS void*)(lds + AUX_BIAS + sl_), 16, lane * 16, (int)E.bias_off(nxt), 0, 0); } } \
            if constexpr (GATHER) { if (last && has_next) { if constexpr (AUX) PG8_GATHER_OFFS_LDS(nxt, ((ui + 1) & 1) * 1024, nx0, nx1); else PG8_GATHER_OFFS(nxt, nx0, nx1); } } \
            PG8_LDB(B0, 0, 0); PG8_LDB(B1, 0, 1); PG8_SCHED; PG8_LDA(At, 0, 0); PG8_STAGE(rsA, PG8_SA(1, 1), a1 + ahstep, voffA1); \
            if constexpr (GATHER) { if (last && has_next) { voffA0[0] = nx0[0]; voffA0[1] = nx0[1]; voffA1[0] = nx1[0]; voffA1[1] = nx1[1]; } } \
            WAITX; \
            PG8_WAIT_L(0); PG8_BAR; PG8_MMA(0, 0, At, B0); PG8_MMA(0, 1, At, B1); PG8_BAR; PG8_SCHED; \
            PG8_LDA(At, 0, 1); PG8_STAGE(rsB, PG8_SB(0, 0), b2, voffB); PG8_STAGE(rsB, PG8_SB(0, 1), b2 + hstep, voffB); PG8_STAGE(rsA, PG8_SA(0, 0), a2, voffA0); \
            WAITX; \
            PG8_WAIT_L(0); PG8_BAR; PG8_MMA(1, 0, At, B0); PG8_MMA(1, 1, At, B1); PG8_BAR; PG8_SCHED; \
            PG8_LDB(B0, 1, 0); PG8_LDB(B1, 1, 1); PG8_SCHED; PG8_LDA(At, 1, 0); PG8_STAGE(rsA, PG8_SA(0, 1), a2 + ahstep, voffA1); \
            PG8_WAIT_V(8); PG8_WAIT_L(0); PG8_BAR; PG8_MMA(0, 0, At, B0); PG8_MMA(0, 1, At, B1); PG8_BAR; PG8_SCHED; \
            PG8_LDA(At, 1, 1); PG8_STAGE(rsB, PG8_SB(1, 0), b3, voffB); PG8_STAGE(rsB, PG8_SB(1, 1), b3 + hstep, voffB); PG8_STAGE(rsA, PG8_SA(1, 0), a3, voffA0); \
            PG8_WAIT_V(8); PG8_WAIT_L(0); PG8_BAR; PG8_MMA(1, 0, At, B0); PG8_MMA(1, 1, At, B1); PG8_BAR; PG8_SCHED; \
        } while (0)
    int sclW = 0x7a7a7a7a, sclA = 0x7f7f7f7f; asm volatile("" : "+v"(sclW), "+v"(sclA));
    Unit cur, nxt; int ui = 0;
    if (!S.next(0, cur)) return;
    if constexpr (Sched::SEG) nt = S.nt_of(cur);
    f32x4 acc[2][2][4][2];
    if constexpr (!Epi::BINIT) {
#pragma unroll
    for (int a = 0; a < 2; ++a)
#pragma unroll
        for (int b = 0; b < 2; ++b)
#pragma unroll
            for (int m = 0; m < 4; ++m)
#pragma unroll
                for (int n = 0; n < 2; ++n) acc[a][b][m][n] = (f32x4){0.f, 0.f, 0.f, 0.f};
    }
    bf16x8 At[4][2], B0[2][2], B1[2][2];
    unsigned cA = GATHER ? 0u : S.A0(cur), cB = S.B0(cur);
#define PG8_GATHER_OFFS(u, o0, o1) do { const int* rl_ = S.rows(u); _Pragma("unroll") for (int i = 0; i < 2; ++i) { int R_, C_; stage_rc(tid * 16 + i * 8192, R_, C_); \
        const int r0_ = R_ < (u).aux ? R_ : 0, r1_ = (R_ + 128) < (u).aux ? (R_ + 128) : 0; o0[i] = rl_[r0_] * RBy + C_ * 2; o1[i] = rl_[r1_] * RBy + C_ * 2; } } while (0)
#define PG8_GATHER_OFFS_LDS(u, slb, o0, o1) do { const LAS int* il_ = (const LAS int*)(lds + AUX_IDS + (slb)); _Pragma("unroll") for (int i = 0; i < 2; ++i) { int R_, C_; stage_rc(tid * 16 + i * 8192, R_, C_); \
        const int r0_ = R_ < (u).aux ? R_ : 0, r1_ = (R_ + 128) < (u).aux ? (R_ + 128) : 0; o0[i] = il_[r0_] * RBy + C_ * 2; o1[i] = il_[r1_] * RBy + C_ * 2; } } while (0)
    if constexpr (GATHER) { PG8_GATHER_OFFS(cur, voffA0, voffA1); }
    if constexpr (AUX) { if (tid < 256) ((LAS float*)(lds + AUX_BIAS))[tid] = ((const float*)((const char*)E.bias_base() + E.bias_off(cur)))[tid]; PG8_WAIT_L(0); }
    PG8_STAGE(rsB, PG8_SB(0, 0), cB, voffB); PG8_STAGE(rsB, PG8_SB(0, 1), cB + hstep, voffB); PG8_STAGE(rsA, PG8_SA(0, 0), cA, voffA0); PG8_STAGE(rsA, PG8_SA(0, 1), cA + ahstep, voffA1);
    if (wr == 1) PG8_BAR;
    PG8_WAIT_V(2); PG8_BAR;
    if constexpr (Epi::BINIT) E.init(acc, wc, fq, (const LAS float*)(lds + AUX_BIAS));
    PG8_STAGE(rsB, PG8_SB(1, 0), cB + kstep, voffB); PG8_STAGE(rsA, PG8_SA(1, 0), cA + kstep, voffA0); PG8_STAGE(rsB, PG8_SB(1, 1), cB + hstep + kstep, voffB);
    PG8_WAIT_V(6); PG8_BAR;
#define PG8_UNIT(EPI_, REINIT_) { \
        const bool has_next = S.next(ui + 1, nxt); \
        const unsigned nA = GATHER ? 0u : (has_next ? S.A0(nxt) : cA), nB = has_next ? S.B0(nxt) : cB; \
          \
        int t = 0; \
        if (ui > 0) { PG8_TRIP(PG8_WAIT_VX()); t = 2; } \
        for (; t < nt; t += 2) { PG8_TRIP(PG8_WAIT_V(8)); } \
        if (Epi::ALIGN && wr == 0) PG8_BAR;                                         \
        PG8_MFMA_DRAIN(); \
        EPI_; \
        if (!has_next) break; \
        REINIT_; \
        cur = nxt; cA = nA; cB = nB; ++ui; \
        if constexpr (Sched::SEG) nt = S.nt_of(cur); \
        if (Epi::ALIGN && wr == 1) PG8_BAR; }
#define PG8_ZERO_ACC() do { _Pragma("unroll") for (int a = 0; a < 2; ++a) _Pragma("unroll") for (int b = 0; b < 2; ++b) _Pragma("unroll") for (int m = 0; m < 4; ++m) _Pragma("unroll") for (int n = 0; n < 2; ++n) \
        acc[a][b][m][n] = (f32x4){0.f, 0.f, 0.f, 0.f}; } while (0)
    for (;;) {
        if constexpr (Sched::SEG) {
            PG8_UNIT(E.mid(acc, cur, wr, wc, fr, fq), (void)0)
            PG8_UNIT(E(acc, cur, wr, wc, fr, fq), PG8_ZERO_ACC())
        } else if constexpr (AUX) {
            PG8_UNIT(E(acc, cur, wr, wc, fr, fq, (const LAS float*)(lds + AUX_BIAS + (ui & 1) * 1024)), E.init(acc, wc, fq, (const LAS float*)(lds + AUX_BIAS + ((ui + 1) & 1) * 1024)))
        } else {
            PG8_UNIT(E(acc, cur, wr, wc, fr, fq), PG8_ZERO_ACC())
        }
    }
#undef PG8_UNIT
#undef PG8_ZERO_ACC
    PG8_WAIT_V(0);
    if (!Epi::ALIGN && wr == 0) PG8_BAR;
    PG8_BAR;
#undef PG8_GATHER_OFFS
#undef PG8_GATHER_OFFS_LDS
#undef PG8_SA
#undef PG8_SB
#undef PG8_STAGE
#undef PG8_LDA
#undef PG8_LDB
#undef PG8_MMA
#undef PG8_CAT
#undef PG8_WAIT_V
#undef PG8_WAIT_VX
#undef PG8_TRIP
#undef PG8_WAIT_L
#undef PG8_BAR
#undef PG8_SCHED
}

__device__ __forceinline__ void swap16(unsigned& a, unsigned& b) { const auto r = __builtin_amdgcn_permlane16_swap(a, b, false, false); a = r[0]; b = r[1]; }
struct EpiProj {
    static constexpr bool PERM = true; static constexpr bool AUX = false; static constexpr bool BINIT = false; static constexpr int NVM = 16; static constexpr bool ALIGN = true;
    bf16 *rkv, *att; unsigned char* gate; bf16* lora;
    static __device__ __forceinline__ f32x2 sg255(f32x2 x) {
        const f32x2 t = x * (f32x2){-1.44269504f, -1.44269504f};
        f32x2 e; e.x = __builtin_amdgcn_exp2f(t.x); e.y = __builtin_amdgcn_exp2f(t.y);
        const f32x2 d = e + (f32x2){1.0f, 1.0f};
        f32x2 r; r.x = __builtin_amdgcn_rcpf(d.x); r.y = __builtin_amdgcn_rcpf(d.y);
        const f32x2 q = r * (f32x2){255.0f, 255.0f} + (f32x2){0.5f, 0.5f};
        return (f32x2){fmaxf(q.x, 1.0f), fmaxf(q.y, 1.0f)};
    }
    __device__ __forceinline__ void operator()(const f32x4 (&acc)[2][2][4][2], const Unit& u, int wr, int wc, int fr, int fq) const {
        const int row0 = u.pm * 256 + wr * 64 + fr;
        if (u.pn >= 15 && u.pn < 23) {
            const int col0 = (u.pn - 15) * 256 + wc * 32 + 8 * fq;
#pragma unroll
            for (int ai = 0; ai < 2; ++ai)
#pragma unroll
                for (int m = 0; m < 4; ++m) { unsigned char* rowp = gate + (size_t)(row0 + ai * 128 + m * 16) * C_GATE + col0;
#pragma unroll
                    for (int bj = 0; bj < 2; ++bj) { const f32x4 v0 = acc[ai][bj][m][0], v1 = acc[ai][bj][m][1];
                        const f32x2 a0 = sg255(v0.xy), a1 = sg255(v0.zw), a2 = sg255(v1.xy), a3 = sg255(v1.zw);
                        v2u w; w.x = __builtin_amdgcn_cvt_pk_u8_f32(a1.y, 3, __builtin_amdgcn_cvt_pk_u8_f32(a1.x, 2, __builtin_amdgcn_cvt_pk_u8_f32(a0.y, 1, __builtin_amdgcn_cvt_pk_u8_f32(a0.x, 0, 0u))));
                        w.y = __builtin_amdgcn_cvt_pk_u8_f32(a3.y, 3, __builtin_amdgcn_cvt_pk_u8_f32(a3.x, 2, __builtin_amdgcn_cvt_pk_u8_f32(a2.y, 1, __builtin_amdgcn_cvt_pk_u8_f32(a2.x, 0, 0u))));
                        *(v2u*)(rowp + bj * 128) = w; } }
            return;
        }
        bf16* base; int ldc, colt;
        if (u.pn < 6) { base = rkv; ldc = C_RKV; colt = u.pn * 256; }
        else if (u.pn < 15) { base = att; ldc = C_ATT; colt = (u.pn - 6) * 256; }
        else { base = lora; ldc = C_LORA; colt = (u.pn - 23) * 256; }
        const int col0 = colt + wc * 32 + 8 * fq;
#pragma unroll
        for (int ai = 0; ai < 2; ++ai)
#pragma unroll
            for (int m = 0; m < 4; ++m) { bf16* rowp = base + (size_t)(row0 + ai * 128 + m * 16) * ldc + col0;
#pragma unroll
                for (int bj = 0; bj < 2; ++bj) { const f32x4 v0 = acc[ai][bj][m][0], v1 = acc[ai][bj][m][1];
                    v4u w; w.x = cvt_pk_bf16(v0[0], v0[1]); w.y = cvt_pk_bf16(v0[2], v0[3]); w.z = cvt_pk_bf16(v1[0], v1[1]); w.w = cvt_pk_bf16(v1[2], v1[3]);
                    *(v4u*)(rowp + bj * 128) = w; } }
    }
};
template <bool FIRST> struct EpiMix {
    static constexpr bool PERM = true; static constexpr bool AUX = false; static constexpr bool BINIT = false; static constexpr int NVM = FIRST ? 32 : 48; static constexpr bool ALIGN = true;
    bf16* mixed; const unsigned char* sg; int gcol;
    __device__ __forceinline__ void operator()(const f32x4 (&acc)[2][2][4][2], const Unit& u, int wr, int wc, int fr, int fq) const {
        const int row0 = u.pm * 256 + wr * 64 + fr, col0 = u.pn * 256 + wc * 32 + 8 * fq;
        const float gs = 1.0f / 255.0f;
#pragma unroll
        for (int ai = 0; ai < 2; ++ai) {
            v2u g[4][2]; v4u o[4][2];
#pragma unroll
            for (int m = 0; m < 4; ++m) { const size_t row = (size_t)(row0 + ai * 128 + m * 16);
#pragma unroll
                for (int bj = 0; bj < 2; ++bj) { g[m][bj] = *(const v2u*)(sg + row * C_GATE + gcol + col0 + bj * 128);
                    o[m][bj] = (v4u){0u, 0u, 0u, 0u}; if (!FIRST) o[m][bj] = *(const v4u*)(mixed + row * D + col0 + bj * 128); } }
#pragma unroll
            for (int m = 0; m < 4; ++m) { const size_t row = (size_t)(row0 + ai * 128 + m * 16);
#pragma unroll
                for (int bj = 0; bj < 2; ++bj) { const v2u gg = g[m][bj]; const v4u oo = o[m][bj];
                    const f32x4 v0 = acc[ai][bj][m][0], v1 = acc[ai][bj][m][1];
                    float r[8];
                    r[0] = (float)(gg.x & 255u) * gs * v0[0]; r[1] = (float)((gg.x >> 8) & 255u) * gs * v0[1]; r[2] = (float)((gg.x >> 16) & 255u) * gs * v0[2]; r[3] = (float)(gg.x >> 24) * gs * v0[3];
                    r[4] = (float)(gg.y & 255u) * gs * v1[0]; r[5] = (float)((gg.y >> 8) & 255u) * gs * v1[1]; r[6] = (float)((gg.y >> 16) & 255u) * gs * v1[2]; r[7] = (float)(gg.y >> 24) * gs * v1[3];
                    if (!FIRST) { r[0] += bf_lo(oo.x); r[1] += bf_hi(oo.x); r[2] += bf_lo(oo.y); r[3] += bf_hi(oo.y); r[4] += bf_lo(oo.z); r[5] += bf_hi(oo.z); r[6] += bf_lo(oo.w); r[7] += bf_hi(oo.w); }
                    v4u w; w.x = cvt_pk_bf16(r[0], r[1]); w.y = cvt_pk_bf16(r[2], r[3]); w.z = cvt_pk_bf16(r[4], r[5]); w.w = cvt_pk_bf16(r[6], r[7]);
                    *(v4u*)(mixed + row * D + col0 + bj * 128) = w; } }
            asm volatile("" ::: "memory"); }
    }
};
struct EpiMixF {
    static constexpr bool PERM = true; static constexpr bool AUX = false; static constexpr bool BINIT = false; static constexpr int NVM = 32; static constexpr bool ALIGN = false;
    bf16* mixed; const unsigned char* sg;
    __device__ __forceinline__ void mid(f32x4 (&acc)[2][2][4][2], const Unit& u, int wr, int wc, int fr, int fq) const {
        const int row0 = u.pm * 256 + wr * 64 + fr, col0 = u.pn * 256 + wc * 32 + 8 * fq;
#pragma unroll
        for (int ai = 0; ai < 2; ++ai) { v2u gr[4][2], ga[4][2];
#pragma unroll
            for (int m = 0; m < 4; ++m) { const unsigned char* p = sg + (size_t)(row0 + ai * 128 + m * 16) * C_GATE + col0;
#pragma unroll
                for (int bj = 0; bj < 2; ++bj) { gr[m][bj] = *(const v2u*)(p + bj * 128); ga[m][bj] = *(const v2u*)(p + 1024 + bj * 128); } }
#pragma unroll
            for (int m = 0; m < 4; ++m)
#pragma unroll
                for (int bj = 0; bj < 2; ++bj) { const v2u r = gr[m][bj], a = ga[m][bj];
                    f32x4& v0 = acc[ai][bj][m][0]; f32x4& v1 = acc[ai][bj][m][1];
                    v0[0] *= (float)(r.x & 255u) * __builtin_amdgcn_rcpf((float)(a.x & 255u)); v0[1] *= (float)((r.x >> 8) & 255u) * __builtin_amdgcn_rcpf((float)((a.x >> 8) & 255u));
                    v0[2] *= (float)((r.x >> 16) & 255u) * __builtin_amdgcn_rcpf((float)((a.x >> 16) & 255u)); v0[3] *= (float)(r.x >> 24) * __builtin_amdgcn_rcpf((float)(a.x >> 24));
                    v1[0] *= (float)(r.y & 255u) * __builtin_amdgcn_rcpf((float)(a.y & 255u)); v1[1] *= (float)((r.y >> 8) & 255u) * __builtin_amdgcn_rcpf((float)((a.y >> 8) & 255u));
                    v1[2] *= (float)((r.y >> 16) & 255u) * __builtin_amdgcn_rcpf((float)((a.y >> 16) & 255u)); v1[3] *= (float)(r.y >> 24) * __builtin_amdgcn_rcpf((float)(a.y >> 24)); }
            asm volatile("" ::: "memory"); }
    }
    __device__ __forceinline__ void operator()(const f32x4 (&acc)[2][2][4][2], const Unit& u, int wr, int wc, int fr, int fq) const {
        const int row0 = u.pm * 256 + wr * 64 + fr, col0 = u.pn * 256 + wc * 32 + 8 * fq;
        const float gs = 1.0f / 255.0f;
#pragma unroll
        for (int ai = 0; ai < 2; ++ai) { v2u g[4][2];
#pragma unroll
            for (int m = 0; m < 4; ++m)
#pragma unroll
                for (int bj = 0; bj < 2; ++bj) g[m][bj] = *(const v2u*)(sg + (size_t)(row0 + ai * 128 + m * 16) * C_GATE + 1024 + col0 + bj * 128);
#pragma unroll
            for (int m = 0; m < 4; ++m) { const size_t row = (size_t)(row0 + ai * 128 + m * 16);
#pragma unroll
                for (int bj = 0; bj < 2; ++bj) { const v2u gg = g[m][bj]; const f32x4 v0 = acc[ai][bj][m][0], v1 = acc[ai][bj][m][1];
                    float r[8];
                    r[0] = (float)(gg.x & 255u) * gs * v0[0]; r[1] = (float)((gg.x >> 8) & 255u) * gs * v0[1]; r[2] = (float)((gg.x >> 16) & 255u) * gs * v0[2]; r[3] = (float)(gg.x >> 24) * gs * v0[3];
                    r[4] = (float)(gg.y & 255u) * gs * v1[0]; r[5] = (float)((gg.y >> 8) & 255u) * gs * v1[1]; r[6] = (float)((gg.y >> 16) & 255u) * gs * v1[2]; r[7] = (float)(gg.y >> 24) * gs * v1[3];
                    v4u w; w.x = cvt_pk_bf16(r[0], r[1]); w.y = cvt_pk_bf16(r[2], r[3]); w.z = cvt_pk_bf16(r[4], r[5]); w.w = cvt_pk_bf16(r[6], r[7]);
                    *(v4u*)(mixed + row * D + col0 + bj * 128) = w; } }
            asm volatile("" ::: "memory"); }
    }
};
struct EpiOut {
    static constexpr bool PERM = true; static constexpr bool AUX = false; static constexpr bool BINIT = false; static constexpr int NVM = 52; static constexpr bool ALIGN = false;
    const float* x; bf16* x1; const float* mod;
    __device__ __forceinline__ void operator()(const f32x4 (&acc)[2][2][4][2], const Unit& u, int wr, int wc, int fr, int fq) const {
        const int row0 = u.pm * 256 + wr * 64 + fr, col0 = u.pn * 256 + wc * 32 + 8 * fq;
        const float* g1 = mod + (size_t)(u.pm >> 3) * 6144 + 2048 + col0;
        f32x4 ga[2], gb[2];
#pragma unroll
        for (int bj = 0; bj < 2; ++bj) { ga[bj] = *(const f32x4*)(g1 + bj * 128); gb[bj] = *(const f32x4*)(g1 + bj * 128 + 4); }
#pragma unroll
        for (int ai = 0; ai < 2; ++ai) { f32x4 xa[4][2], xb[4][2];
#pragma unroll
            for (int m = 0; m < 4; ++m)
#pragma unroll
                for (int bj = 0; bj < 2; ++bj) { const size_t off = (size_t)(row0 + ai * 128 + m * 16) * D + col0 + bj * 128; xa[m][bj] = *(const f32x4*)(x + off); xb[m][bj] = *(const f32x4*)(x + off + 4); }
#pragma unroll
            for (int m = 0; m < 4; ++m)
#pragma unroll
                for (int bj = 0; bj < 2; ++bj) { const size_t off = (size_t)(row0 + ai * 128 + m * 16) * D + col0 + bj * 128;
                    const f32x4 ra = xa[m][bj] + ga[bj] * acc[ai][bj][m][0], rb = xb[m][bj] + gb[bj] * acc[ai][bj][m][1];
                    v4u w; w.x = cvt_pk_bf16(ra[0], ra[1]); w.y = cvt_pk_bf16(ra[2], ra[3]); w.z = cvt_pk_bf16(rb[0], rb[1]); w.w = cvt_pk_bf16(rb[2], rb[3]);
                    *(v4u*)(x1 + off) = w; }
            asm volatile("" ::: "memory"); }
    }
};
struct EpiSwiglu {
    static constexpr bool PERM = true; static constexpr int NVM = 4; static constexpr bool AUX = true; static constexpr bool BINIT = true; static constexpr bool ALIGN = false;
    unsigned char* act; const float* b1p;
    __device__ __forceinline__ const float* bias_base() const { return b1p; }
    __device__ __forceinline__ unsigned bias_off(const Unit& u) const { return (unsigned)((u.e * 2048 + u.pn * 256) * 4); }
    __device__ __forceinline__ void init(f32x4 (&acc)[2][2][4][2], int wc, int fq, const LAS float* lb) const {
        const LAS float* bb = lb + wc * 32 + 8 * fq;
        const f32x4 one = (f32x4){1.f, 1.f, 1.f, 1.f};
        const f32x4 bg0 = *(const LAS f32x4*)(bb), bg1 = *(const LAS f32x4*)(bb + 4), bl0 = *(const LAS f32x4*)(bb + 128) + one, bl1 = *(const LAS f32x4*)(bb + 132) + one;
#pragma unroll
        for (int a = 0; a < 2; ++a)
#pragma unroll
            for (int m = 0; m < 4; ++m) { acc[a][0][m][0] = bg0; acc[a][0][m][1] = bg1; acc[a][1][m][0] = bl0; acc[a][1][m][1] = bl1; }
    }
    static __device__ __forceinline__ f32x2 sw2(f32x2 g, f32x2 l) {
        f32x2 gm; gm.x = __builtin_amdgcn_fmed3f(g.x, -3.0e38f, 7.0f); gm.y = __builtin_amdgcn_fmed3f(g.y, -3.0e38f, 7.0f);
        const f32x2 t = gm * (f32x2){-2.45546696f, -2.45546696f};
        f32x2 e; e.x = __builtin_amdgcn_exp2f(t.x); e.y = __builtin_amdgcn_exp2f(t.y);
        const f32x2 d = e + (f32x2){1.0f, 1.0f};
        f32x2 r; r.x = __builtin_amdgcn_rcpf(d.x); r.y = __builtin_amdgcn_rcpf(d.y);
        f32x2 lm; lm.x = __builtin_amdgcn_fmed3f(l.x, -6.0f, 8.0f); lm.y = __builtin_amdgcn_fmed3f(l.y, -6.0f, 8.0f);
        return (gm * r) * lm;
    }
    __device__ __forceinline__ void operator()(const f32x4 (&acc)[2][2][4][2], const Unit& u, int wr, int wc, int fr, int fq, const LAS float* lb) const {
        const int row0 = u.pm * 256 + wr * 64 + fr;
#pragma unroll
        for (int ai = 0; ai < 2; ++ai)
#pragma unroll
            for (int mp = 0; mp < 2; ++mp) { v2u w[2];
#pragma unroll
                for (int q = 0; q < 2; ++q) { const int m = mp * 2 + q;
                    const f32x4 g0 = acc[ai][0][m][0], g1 = acc[ai][0][m][1], l0 = acc[ai][1][m][0], l1 = acc[ai][1][m][1];
                    const f32x2 r0 = sw2(g0.xy, l0.xy), r1 = sw2(g0.zw, l0.zw), r2 = sw2(g1.xy, l1.xy), r3 = sw2(g1.zw, l1.zw);
                    w[q].x = pk4_fp8(r0.x, r0.y, r1.x, r1.y); w[q].y = pk4_fp8(r2.x, r2.y, r3.x, r3.y); }
                unsigned x0 = w[0].x, x1 = w[0].y, y0 = w[1].x, y1 = w[1].y; swap16(x0, y0); swap16(x1, y1);
                *(v4u*)(act + (size_t)(row0 + ai * 128 + (mp * 2 + (fq & 1)) * 16) * D + u.pn * 128 + wc * 32 + 8 * (fq & 2)) = (v4u){x0, x1, y0, y1}; }
    }
};
struct EpiDown {
    static constexpr bool PERM = true; static constexpr int NVM = 8; static constexpr bool AUX = true; static constexpr bool BINIT = true; static constexpr bool ALIGN = true;
    unsigned char* O; const float* b2;
    __device__ __forceinline__ const float* bias_base() const { return b2; }
    __device__ __forceinline__ unsigned bias_off(const Unit& u) const { return (unsigned)((u.e * 1024 + u.pn * 256) * 4); }
    __device__ __forceinline__ void init(f32x4 (&acc)[2][2][4][2], int wc, int fq, const LAS float* lb) const {
        const LAS float* bb = lb + wc * 32 + 8 * fq;
        const f32x4 b00 = *(const LAS f32x4*)(bb), b01 = *(const LAS f32x4*)(bb + 4), b10 = *(const LAS f32x4*)(bb + 128), b11 = *(const LAS f32x4*)(bb + 132);
#pragma unroll
        for (int a = 0; a < 2; ++a)
#pragma unroll
            for (int m = 0; m < 4; ++m) { acc[a][0][m][0] = b00; acc[a][0][m][1] = b01; acc[a][1][m][0] = b10; acc[a][1][m][1] = b11; }
    }
    __device__ __forceinline__ void operator()(const f32x4 (&acc)[2][2][4][2], const Unit& u, int wr, int wc, int fr, int fq, const LAS float*) const {
        const int row0 = u.pm * 256 + wr * 64 + fr, col0 = u.pn * 256 + wc * 32 + 8 * (fq & 2);
#pragma unroll
        for (int ai = 0; ai < 2; ++ai)
#pragma unroll
            for (int mp = 0; mp < 2; ++mp) { unsigned char* rowp = O + (size_t)(row0 + ai * 128 + (mp * 2 + (fq & 1)) * 16) * D + col0;
#pragma unroll
                for (int bj = 0; bj < 2; ++bj) { v2u w[2];
#pragma unroll
                    for (int q = 0; q < 2; ++q) { const f32x4 v0 = acc[ai][bj][mp * 2 + q][0], v1 = acc[ai][bj][mp * 2 + q][1];
                        w[q].x = pk4_fp8(v0[0], v0[1], v0[2], v0[3]); w[q].y = pk4_fp8(v1[0], v1[1], v1[2], v1[3]); }
                    unsigned x0 = w[0].x, x1 = w[0].y, y0 = w[1].x, y1 = w[1].y; swap16(x0, y0); swap16(x1, y1);
                    *(v4u*)(rowp + bj * 128) = (v4u){x0, x1, y0, y1}; } }
    }
};
}

struct Args { const float* in[34]; float* out; unsigned char* ws; int ph_lo, ph_hi; };
struct Frame {
    LAS unsigned char* lds; volatile LAS unsigned* MISC; unsigned* ctl; unsigned char* ws; unsigned char* dout;
    int tid, lane, wave, G, bx;
};
enum InIdx { I_X = 0, I_C, I_ADAW, I_ADAB, I_N1G, I_N2G, I_WIN, I_MURKV, I_MUWAG, I_W0, I_W1, I_W2, I_A0, I_A1, I_A2, I_G1, I_G2, I_KK, I_KA, I_RK, I_LNW, I_LNB, I_QNG, I_KNG, I_RELB,
             I_WBRR, I_WBRA, I_WOUT, I_RTW, I_RTB, I_EW1, I_EB1, I_EW2, I_EB2 };

template <class DM, class RS>
__device__ __forceinline__ void transpose_item(const float* W, int ldw, int K, bf16* WT, int k0, int n0, LAS float* scr, int lane, const DM& dmap, const RS& rs) {
    const int cq = lane & 7, kr = lane >> 3;
#pragma unroll
    for (int i = 0; i < 8; ++i) { const int kk = 8 * i + kr; const f32x4 v = *(const f32x4*)(W + (size_t)(k0 + kk) * ldw + n0 + 4 * cq) * rs(k0 + kk);
        LAS float* d = scr + kk * 33 + 4 * cq; d[0] = v[0]; d[1] = v[1]; d[2] = v[2]; d[3] = v[3]; }
    LDS_WAIT(); asm volatile("" ::: "memory");
    const int c = lane & 7;
#pragma unroll
    for (int j = 0; j < 4; ++j) { const int n = (lane >> 3) + 8 * j; const LAS float* s = scr + (8 * c) * 33 + n;
        v4u o; o.x = cvt_pk_bf16(s[0 * 33], s[1 * 33]); o.y = cvt_pk_bf16(s[2 * 33], s[3 * 33]); o.z = cvt_pk_bf16(s[4 * 33], s[5 * 33]); o.w = cvt_pk_bf16(s[6 * 33], s[7 * 33]);
        *(v4u*)(WT + (size_t)dmap(n0 + n) * K + k0 + 8 * c) = o; }
    LDS_WAIT(); asm volatile("" ::: "memory");
}
template <class DM, class RS>
__device__ __forceinline__ void transpose_item_fp8(const float* W, int ldw, int K, unsigned char* WT8, int k0, int n0, LAS float* scr, int lane, const DM& dmap, const RS& rs) {
    const int cq = lane & 7, kr = lane >> 3;
#pragma unroll
    for (int i = 0; i < 8; ++i) { const int kk = 8 * i + kr; const f32x4 v = *(const f32x4*)(W + (size_t)(k0 + kk) * ldw + n0 + 4 * cq) * (32.0f * rs(k0 + kk));
        LAS float* d = scr + kk * 33 + 4 * cq; d[0] = v[0]; d[1] = v[1]; d[2] = v[2]; d[3] = v[3]; }
    LDS_WAIT(); asm volatile("" ::: "memory");
    const int c = lane & 3;
#pragma unroll
    for (int j = 0; j < 2; ++j) { const int n = (lane >> 2) + 16 * j; const LAS float* s = scr + (16 * c) * 33 + n;
        v4u o; o.x = pk4_fp8(s[0 * 33], s[1 * 33], s[2 * 33], s[3 * 33]); o.y = pk4_fp8(s[4 * 33], s[5 * 33], s[6 * 33], s[7 * 33]);
        o.z = pk4_fp8(s[8 * 33], s[9 * 33], s[10 * 33], s[11 * 33]); o.w = pk4_fp8(s[12 * 33], s[13 * 33], s[14 * 33], s[15 * 33]);
        *(v4u*)(WT8 + (size_t)dmap(n0 + n) * K + k0 + 16 * c) = o; }
    LDS_WAIT(); asm volatile("" ::: "memory");
}
struct CmId { __device__ __forceinline__ int operator()(int n) const { return n; } };
struct CmGlu { __device__ __forceinline__ int operator()(int n) const { const int pn = n >> 8, t = n & 255; return 2 * (pn * 128 + (t & 127)) + (t >> 7); } };
struct DmGlu { __device__ __forceinline__ int operator()(int n) const { const int pn = n >> 8, l = n & 255; return pn * 256 + (l & 1) * 128 + (l >> 1); } };
struct RsOne { __device__ __forceinline__ float operator()(int) const { return 1.0f; } };
struct RsMu { const float* mu; float a, b; __device__ __forceinline__ float operator()(int k) const { return a + b * mu[k]; } };

__device__ __forceinline__ void p0_prologue(Frame& F, const Args& A) {
    unsigned char* ws = F.ws;
    const int gw = F.bx * 8 + F.wave, NGW = F.G * 8;
    __syncthreads();
    {
        LAS float* sc = (LAS float*)F.lds;
        const float* c = A.in[I_C];
        for (int i = ((int)threadIdx.x); i < 32 * 1024; i += 512) { const int b = i >> 10, k = i & 1023; const float v = c[i]; sc[k * 32 + b] = v * sigmoidf_(v); }
        __syncthreads();
        const int ks = ((int)threadIdx.x) >> 5, jc = ((int)threadIdx.x) & 31;
        float accv[32];
#pragma unroll
        for (int b = 0; b < 32; ++b) accv[b] = 0.f;
        for (int col0 = F.bx * 24; col0 < 6144; col0 += F.G * 24) {
            if (jc < 24) {
                const float* w = A.in[I_ADAW] + col0 + jc;
                for (int kk0 = 0; kk0 < 64; kk0 += 16) { float wv[16];
#pragma unroll
                    for (int q = 0; q < 16; ++q) wv[q] = w[(size_t)(ks * 64 + kk0 + q) * 6144];
#pragma unroll
                    for (int q = 0; q < 16; ++q) { const int k = ks * 64 + kk0 + q;
#pragma unroll
                        for (int b4 = 0; b4 < 8; ++b4) { const f32x4 s4 = *(const LAS f32x4*)(sc + k * 32 + b4 * 4);
                            accv[b4 * 4 + 0] += s4[0] * wv[q]; accv[b4 * 4 + 1] += s4[1] * wv[q]; accv[b4 * 4 + 2] += s4[2] * wv[q]; accv[b4 * 4 + 3] += s4[3] * wv[q]; } } }
            }
            LAS float* rb = (LAS float*)(F.lds + 131072);
            for (int bq = 0; bq < 4; ++bq) {
                if (jc < 24) {
#pragma unroll
                    for (int b = 0; b < 8; ++b) rb[(ks * 24 + jc) * 8 + b] = accv[bq * 8 + b]; }
                __syncthreads();
                if (((int)threadIdx.x) < 24 * 8) { const int j = ((int)threadIdx.x) >> 3, b = ((int)threadIdx.x) & 7; float s = 0.f;
#pragma unroll
                    for (int q = 0; q < 16; ++q) s += rb[(q * 24 + j) * 8 + b];
                    ((float*)(ws + WS_MOD))[(size_t)(bq * 8 + b) * 6144 + col0 + j] = s + A.in[I_ADAB][col0 + j]; }
                __syncthreads();
            }
#pragma unroll
            for (int b = 0; b < 32; ++b) accv[b] = 0.f;
        }
        __syncthreads();
    }
    {
        LAS float* scr = (LAS float*)(F.lds + F.wave * 16384);
        unsigned char* wext = (unsigned char*)(ws + WS_WEXT);
        const float* mu = A.in[I_MUWAG];
        constexpr int IT_WIN = 16 * 184, IT_LORA = 16 * 16, IT_W1 = 32 * 16 * 64, IT_W2 = 32 * 16 * 32, IT_BRR = 8 * 32, IT_BRA = 4 * 32, IT_OUT = 16 * 32, IT_L2 = 16 + 16 + 32;
        constexpr int NIT = IT_WIN + IT_LORA + IT_W1 + IT_W2 + IT_BRR + IT_BRA + IT_OUT + IT_L2;
        for (int it = gw; it < NIT; it += NGW) {
            int r = it;
            if (r < IT_WIN) { const int kb = r / 184, nb = r % 184; transpose_item_fp8(A.in[I_WIN], 5888, 1024, wext, 64 * kb, 32 * nb, scr, ((int)threadIdx.x & 63), CmId{}, RsOne{}); continue; } r -= IT_WIN;
            if (r < IT_LORA) {
                const int kb = r / 16, nb = r % 16, prev = nb >> 3, q = nb & 7;
                const float* src; int ldw, n0, mi;
                if (q < 2) { src = A.in[I_W1]; ldw = 64; n0 = 32 * q; mi = 0; } else if (q < 4) { src = A.in[I_A1]; ldw = 64; n0 = 32 * (q - 2); mi = 1; } else { src = A.in[I_G1]; ldw = 128; n0 = 32 * (q - 4); mi = 2; }
                const RsMu rs{mu + mi * 1024, prev ? 0.f : 1.f, prev ? 1.f : -1.f};
                transpose_item_fp8(src, ldw, 1024, wext + (size_t)(5888 + 32 * nb - n0) * 1024, 64 * kb, n0, scr, ((int)threadIdx.x & 63), CmId{}, rs); continue; } r -= IT_LORA;
            if (r < IT_W1) { const int e = r / 1024, q = r % 1024, kb = q / 64, nb = q % 64;
                transpose_item_fp8(A.in[I_EW1] + (size_t)e * 1024 * 2048, 2048, 1024, (unsigned char*)(ws + WS_W1T) + (size_t)e * 2048 * 1024, 64 * kb, 32 * nb, scr, ((int)threadIdx.x & 63), DmGlu{}, RsOne{}); continue; } r -= IT_W1;
            if (r < IT_W2) { const int e = r / 512, q = r % 512, kb = q / 32, nb = q % 32;
                transpose_item_fp8(A.in[I_EW2] + (size_t)e * 1024 * 1024, 1024, 1024, (unsigned char*)(ws + WS_W2E) + (size_t)e * 1024 * 1024, 64 * kb, 32 * nb, scr, ((int)threadIdx.x & 63), CmId{}, RsOne{}); continue; } r -= IT_W2;
            if (r < IT_BRR) { const int kb = r / 32, nb = r % 32; transpose_item(A.in[I_WBRR], 1024, 768, (bf16*)(ws + WS_WBRR), 64 * kb, 32 * nb, scr, ((int)threadIdx.x & 63), CmId{}, RsOne{}); continue; } r -= IT_BRR;
            if (r < IT_BRA) { const int kb = r / 32, nb = r % 32; transpose_item(A.in[I_WBRA], 1024, 768, (bf16*)(ws + WS_WBRR) + 512, 64 * kb, 32 * nb, scr, ((int)threadIdx.x & 63), CmId{}, RsOne{}); continue; } r -= IT_BRA;
            if (r < IT_OUT) { const int kb = r / 32, nb = r % 32; transpose_item(A.in[I_WOUT], 1024, 1024, (bf16*)(ws + WS_WOUT), 64 * kb, 32 * nb, scr, ((int)threadIdx.x & 63), CmId{}, RsOne{}); continue; } r -= IT_OUT;
            if (r < 16) { transpose_item(A.in[I_W2], 512, 64, (bf16*)(ws + WS_W2T), 0, 32 * r, scr, ((int)threadIdx.x & 63), CmId{}, RsOne{}); continue; } r -= 16;
            if (r < 16) { transpose_item(A.in[I_A2], 512, 64, (bf16*)(ws + WS_A2T), 0, 32 * r, scr, ((int)threadIdx.x & 63), CmId{}, RsOne{}); continue; } r -= 16;
            { const int kb = r / 16, nb = r % 16; transpose_item(A.in[I_G2], 512, 128, (bf16*)(ws + WS_G2T), 64 * kb, 32 * nb, scr, ((int)threadIdx.x & 63), CmId{}, RsOne{}); }
        }
    }
    {
        const CmGlu cm; float* b1p = (float*)(ws + WS_B1P);
        for (int i = F.bx * 512 + ((int)threadIdx.x); i < 32 * 2048; i += F.G * 512) { const int e = i >> 11, n = i & 2047; b1p[i] = A.in[I_EB1][e * 2048 + cm(n)]; }
        if (F.bx == 0) { float* lut = (float*)(ws + WS_LUT);
            for (int i = ((int)threadIdx.x); i < 12 * 132; i += 512) { const int hd = i / 132, st = i % 132; float v = 0.f;
                if (st <= 128) { const int gi = hd >> 2, dil = gi == 0 ? 1 : (gi == 1 ? 4 : 16), dist = st * dil; int bucket;
                    if (dist < 16) bucket = dist; else { const int lg = 16 + (int)(logf((float)dist / 16.0f) / logf(128.0f) * 16.0f); bucket = lg < 31 ? lg : 31; }
                    v = A.in[I_RELB][bucket * 12 + hd]; }
                lut[i] = v; } }
    }
}

__device__ __forceinline__ void p1_norm(Frame& F, const Args& A) {
    const float* mod = (const float*)(F.ws + WS_MOD);
    unsigned char* H = (unsigned char*)(F.dout + DO_H);
    for (int blk = F.bx; blk < NTOK / 256; blk += F.G) {
        const int b = blk >> 3; const float* md = mod + (size_t)b * 6144;
        f32x4 gs[4], sh[4];
#pragma unroll
        for (int j = 0; j < 4; ++j) { const int k = 4 * ((int)threadIdx.x & 63) + 256 * j; const f32x4 g = *(const f32x4*)(A.in[I_N1G] + k), sc = *(const f32x4*)(md + 1024 + k); gs[j] = g * (sc + 1.0f); sh[j] = *(const f32x4*)(md + k); }
        for (int rr = 0; rr < 32; ++rr) {
            const size_t row = (size_t)blk * 256 + F.wave * 32 + rr;
            const f32x4* xr = (const f32x4*)(A.in[I_X] + row * D) + ((int)threadIdx.x & 63);
            f32x4 v[4]; float s = 0.f;
#pragma unroll
            for (int j = 0; j < 4; ++j) { v[j] = xr[64 * j]; s += (v[j][0] * v[j][0] + v[j][1] * v[j][1]) + (v[j][2] * v[j][2] + v[j][3] * v[j][3]); }
            const float rstd = rsqrtf(wave_sum(s) * (1.0f / D) + 1e-6f);
            unsigned w4[4];
#pragma unroll
            for (int j = 0; j < 4; ++j) { const f32x4 y = v[j] * rstd * gs[j] + sh[j]; w4[j] = pk4_fp8(y[0], y[1], y[2], y[3]); }
            const int ln = ((int)threadIdx.x & 63);
            *(v4u*)(H + row * D + 256 * (ln & 3) + 16 * (ln >> 2)) = quad_transpose(w4[0], w4[1], w4[2], w4[3], ln);
        }
    }
}

constexpr int RK_T = 64;
constexpr int R_AW = 0, R_AA = 9216, R_AG = 18432;
constexpr int R_BHT = 0, R_KHT = 10240, R_VT = 20480;
constexpr int R_WL = 35840, R_AL = R_WL + 16384;
constexpr int R_AT = 35840, R_RT = R_AT + 9216, R_BT = R_RT + 9216, R_KT = R_BT + 9216;
constexpr int R_AKV = R_BT;
constexpr int R_GG = 72704;
constexpr int R_LD = R_GG + 16384;
constexpr int R_YB = R_LD;
constexpr int R_AAB = R_LD + 16384;
constexpr int R_AAK = R_AAB + 8192, R_ARB = R_AAK + 5120, R_ARK = R_ARB + 5120;
constexpr int R_TT = R_ARK + 5120;
constexpr int R_LAM = R_TT + 5120;
constexpr int R_CST = R_LAM + 512;
constexpr int R_EX = R_CST + 2560;
constexpr int R_END = R_EX + 16384;
constexpr int R_AL2 = R_AAB;
static_assert(R_END <= MISC_OFF && R_KT + 9216 <= R_GG, "rwkv LDS map");

__device__ __forceinline__ bf16x8 ldsA_nat(const LAS unsigned char* p) { return *(const LAS bf16x8*)p; }
__device__ __forceinline__ bf16x8 ldsA_perm(const LAS unsigned char* p) {
    const v2u lo = *(const LAS v2u*)p, hi = *(const LAS v2u*)(p + 16); const v4u w = (v4u){lo.x, lo.y, hi.x, hi.y}; return __builtin_bit_cast(bf16x8, w); }
__device__ __forceinline__ bf16x8 acc_frag(const f32x16& x, int s) {
    v4u w; w.x = cvt_pk_bf16(x[8 * s + 0], x[8 * s + 1]); w.y = cvt_pk_bf16(x[8 * s + 2], x[8 * s + 3]); w.z = cvt_pk_bf16(x[8 * s + 4], x[8 * s + 5]); w.w = cvt_pk_bf16(x[8 * s + 6], x[8 * s + 7]);
    return __builtin_bit_cast(bf16x8, w); }

__device__ __forceinline__ void p3_rwkv(Frame& F, const Args& A) {
    LAS unsigned char* L = F.lds;
    const bf16* prkv = (const bf16*)(F.ws + WS_PRKV);
    const bf16* plora = (const bf16*)(F.dout + DO_PLORA);
    bf16* yr = (bf16*)(F.dout + DO_YR);
    const int tid = ((int)threadIdx.x), lane = ((int)threadIdx.x & 63), wave = F.wave, r32 = lane & 31, hh = lane >> 5;
    for (int unit = F.bx; unit < BATCH * 8; unit += F.G) {
        const int b = unit >> 3, h = unit & 7;
        const bf16* w2t = (const bf16*)(F.ws + WS_W2T) + (size_t)h * 64 * 64; const bf16* a2t = (const bf16*)(F.ws + WS_A2T) + (size_t)h * 64 * 64; const bf16* g2t = (const bf16*)(F.ws + WS_G2T) + (size_t)h * 64 * 128;
        const int tt = tid >> 3, cg = tid & 7, ch = h * 64 + 8 * cg;
        f32x16 Hacc[2]; Hacc[0] = (f32x16){}; Hacc[1] = (f32x16){};
        v4u pl[8], pr[6];
#define RK_BAR() asm volatile("s_waitcnt lgkmcnt(0)\n\ts_barrier" ::: "memory")
#define RK_PREFETCH(t0) do { const size_t tokc = (size_t)b * SEQ + (t0) + tt; const bool hp = ((t0) + tt) > 0; \
            const bf16* lc = plora + tokc * C_LORA + 8 * cg; const bf16* lp = plora + (tokc - 1) * C_LORA + 256 + 8 * cg; \
            _Pragma("unroll") for (int q = 0; q < 4; ++q) { pl[q] = *(const v4u*)(lc + 64 * q); pl[4 + q] = hp ? *(const v4u*)(lp + 64 * q) : (v4u){0u, 0u, 0u, 0u}; } \
            const bf16* rc = prkv + tokc * C_RKV + ch; const bf16* rp = prkv + (tokc - 1) * C_RKV + ch; \
            _Pragma("unroll") for (int q = 0; q < 3; ++q) { pr[q] = *(const v4u*)(rc + 512 * q); pr[3 + q] = hp ? *(const v4u*)(rp + 512 * q) : (v4u){0u, 0u, 0u, 0u}; } } while (0)
        v4u ypend = (v4u){0u, 0u, 0u, 0u};
        RK_PREFETCH(0);
        for (int i = tid; i < 640; i += 512) { const int ar = i >> 6, c = i & 63;
            const float* src = ar < 3 ? A.in[I_MURKV] + 512 * ar : ar == 3 ? A.in[I_W0] : ar == 4 ? A.in[I_A0] : ar == 5 ? A.in[I_KK] : ar == 6 ? A.in[I_KA] : ar == 7 ? A.in[I_RK] : ar == 8 ? A.in[I_LNW] : A.in[I_LNB];
            ((LAS float*)(L + R_CST))[i] = src[h * 64 + c]; }
        __syncthreads();
        for (int t0 = 0; t0 < SEQ; t0 += RK_T) {
            int zz; asm volatile("v_mov_b32 %0, 0" : "=v"(zz));
            const int chz = ch + zz, hhz = hh + zz, r32z = r32 + zz, lanez = lane + zz, ttz = tt + zz, cgz = cg + zz;
            v4u bwf[4], bgf[8];
            { const int ct_ = wave & 1; const bf16* Bsrc_ = (wave < 4) ? w2t : a2t;
#pragma unroll
              for (int s_ = 0; s_ < 4; ++s_) bwf[s_] = *(const v4u*)(Bsrc_ + (size_t)(ct_ * 32 + r32z) * 64 + 16 * s_ + 8 * hhz);
#pragma unroll
              for (int s_ = 0; s_ < 8; ++s_) bgf[s_] = (wave < 4) ? *(const v4u*)(g2t + (size_t)(ct_ * 32 + r32z) * 128 + 16 * s_ + 8 * hhz) : (v4u){0u, 0u, 0u, 0u}; }
            {
#pragma unroll
                for (int q = 0; q < 4; ++q) { const v4u c = pl[q], p = pl[4 + q]; float s[8];
                    s[0] = bf_lo(c.x) + bf_lo(p.x); s[1] = bf_hi(c.x) + bf_hi(p.x); s[2] = bf_lo(c.y) + bf_lo(p.y); s[3] = bf_hi(c.y) + bf_hi(p.y);
                    s[4] = bf_lo(c.z) + bf_lo(p.z); s[5] = bf_hi(c.z) + bf_hi(p.z); s[6] = bf_lo(c.w) + bf_lo(p.w); s[7] = bf_hi(c.w) + bf_hi(p.w);
                    if (q == 0) {
#pragma unroll
                        for (int j = 0; j < 8; ++j) s[j] = 1.0f - 2.0f * __builtin_amdgcn_rcpf(1.0f + __expf(2.0f * s[j])); }
                    else if (q >= 2) {
#pragma unroll
                        for (int j = 0; j < 8; ++j) s[j] = sigmoidf_(s[j]); }
                    v4u o; o.x = cvt_pk_bf16(s[0], s[1]); o.y = cvt_pk_bf16(s[2], s[3]); o.z = cvt_pk_bf16(s[4], s[5]); o.w = cvt_pk_bf16(s[6], s[7]);
                    LAS unsigned char* dst = (q == 0) ? (L + R_AW + ttz * 144 + cgz * 16) : (q == 1) ? (L + R_AA + ttz * 144 + cgz * 16) : (L + R_AG + ttz * 272 + (q - 2) * 128 + cgz * 16);
                    *(LAS v4u*)dst = o; }
            }
            float r8[8], k8[8], v8[8], a8[8], b8[8]; float bonus;
            {
                const LAS float* cs = (const LAS float*)(L + R_CST) + 8 * cgz;
                const f32x4 m0 = *(const LAS f32x4*)(cs), m1 = *(const LAS f32x4*)(cs + 4), m2 = *(const LAS f32x4*)(cs + 64), m3 = *(const LAS f32x4*)(cs + 68), m4 = *(const LAS f32x4*)(cs + 128), m5 = *(const LAS f32x4*)(cs + 132);
                const float mur[8] = {m0[0], m0[1], m0[2], m0[3], m1[0], m1[1], m1[2], m1[3]}, muk[8] = {m2[0], m2[1], m2[2], m2[3], m3[0], m3[1], m3[2], m3[3]}, muv[8] = {m4[0], m4[1], m4[2], m4[3], m5[0], m5[1], m5[2], m5[3]};
#define UNPK8(dst, u) do { dst[0] = bf_lo(u.x); dst[1] = bf_hi(u.x); dst[2] = bf_lo(u.y); dst[3] = bf_hi(u.y); dst[4] = bf_lo(u.z); dst[5] = bf_hi(u.z); dst[6] = bf_lo(u.w); dst[7] = bf_hi(u.w); } while (0)
                float c8[8], p8[8];
                UNPK8(c8, pr[0]); UNPK8(p8, pr[3]);
#pragma unroll
                for (int j = 0; j < 8; ++j) r8[j] = c8[j] + (p8[j] - c8[j]) * mur[j];
                UNPK8(c8, pr[1]); UNPK8(p8, pr[4]);
#pragma unroll
                for (int j = 0; j < 8; ++j) k8[j] = c8[j] + (p8[j] - c8[j]) * muk[j];
                UNPK8(c8, pr[2]); UNPK8(p8, pr[5]);
#pragma unroll
                for (int j = 0; j < 8; ++j) v8[j] = c8[j] + (p8[j] - c8[j]) * muv[j];
            }
            RK_BAR();
            {
                const int rt = (wave >> 1) & 1, ct = wave & 1;
                const LAS unsigned char* Ab = L + ((wave < 4) ? R_AW : R_AA) + (rt * 32 + r32z) * 144 + hhz * 16;
                f32x16 acc = {};
#pragma unroll
                for (int s = 0; s < 4; ++s) acc = __builtin_amdgcn_mfma_f32_32x32x16_bf16(*(const LAS bf16x8*)(Ab + s * 32), __builtin_bit_cast(bf16x8, bwf[s]), acc, 0, 0, 0);
                if (wave >= 4) { LAS float* o = (LAS float*)(L + R_AL2);
#pragma unroll
                    for (int r = 0; r < 16; ++r) o[(rt * 32 + crow(r, hhz)) * 64 + ct * 32 + r32z] = acc[r]; }
                else {
                    const float w0c = ((const LAS float*)(L + R_CST))[192 + ct * 32 + r32z];
                    float x[16], S[4], O[4];
#pragma unroll
                    for (int r = 0; r < 16; ++r) x[r] = -0.87505297f * __builtin_amdgcn_rcpf(1.0f + __builtin_amdgcn_exp2f(-1.44269504f * (w0c + acc[r])));
#pragma unroll
                    for (int g = 0; g < 4; ++g) { S[g] = (x[4 * g] + x[4 * g + 1]) + (x[4 * g + 2] + x[4 * g + 3]); O[g] = __shfl_xor(S[g], 32); }
                    LAS float* oc = (LAS float*)(L + R_LD) + (rt * 32 + 4 * hhz) * 64 + ct * 32 + r32z; LAS float* oe = (LAS float*)(L + R_EX) + (rt * 32 + 4 * hhz) * 64 + ct * 32 + r32z;
                    float E = 0.f;
#pragma unroll
                    for (int g = 0; g < 4; ++g) { float run = E + (hhz ? O[g] : 0.f);
#pragma unroll
                        for (int q = 0; q < 4; ++q) { oe[(8 * g + q) * 64] = run; run += x[4 * g + q]; oc[(8 * g + q) * 64] = run; }
                        E += S[g] + O[g]; }
                    if (hhz == 0) ((LAS float*)(L + R_LAM))[rt * 64 + ct * 32 + r32z] = __builtin_amdgcn_exp2f(E);
                }
                if (wave < 4) {
                    const LAS unsigned char* Ag = L + R_AG + (rt * 32 + r32z) * 272 + hhz * 16;
                    f32x16 accg = {};
#pragma unroll
                    for (int s = 0; s < 8; ++s) accg = __builtin_amdgcn_mfma_f32_32x32x16_bf16(*(const LAS bf16x8*)(Ag + s * 32), __builtin_bit_cast(bf16x8, bgf[s]), accg, 0, 0, 0);
                    LAS float* og = (LAS float*)(L + R_GG);
#pragma unroll
                    for (int r = 0; r < 16; ++r) og[(rt * 32 + crow(r, hhz)) * 64 + ct * 32 + r32z] = accg[r];
                }
            }
            RK_BAR();
            if (t0 > 0) *(v4u*)(yr + ((size_t)b * SEQ + (t0 - RK_T) + ttz) * C_YC + ch) = ypend;
            if (t0 + RK_T < SEQ) RK_PREFETCH(t0 + RK_T);
            {
                const LAS float* al = (const LAS float*)(L + R_AL2) + ttz * 64 + 8 * cgz;
                const f32x4 al0 = *(const LAS f32x4*)al, al1 = *(const LAS f32x4*)(al + 4);
                const float alv[8] = {al0[0], al0[1], al0[2], al0[3], al1[0], al1[1], al1[2], al1[3]};
                const LAS float* cs = (const LAS float*)(L + R_CST) + 256 + 8 * cgz;
                const f32x4 c2 = *(const LAS f32x4*)(cs), c3 = *(const LAS f32x4*)(cs + 4),
                            c4 = *(const LAS f32x4*)(cs + 64), c5 = *(const LAS f32x4*)(cs + 68), c6 = *(const LAS f32x4*)(cs + 128), c7 = *(const LAS f32x4*)(cs + 132),
                            c8_ = *(const LAS f32x4*)(cs + 192), c9 = *(const LAS f32x4*)(cs + 196);
                const float a0v[8] = {c2[0], c2[1], c2[2], c2[3], c3[0], c3[1], c3[2], c3[3]}, kkc[8] = {c4[0], c4[1], c4[2], c4[3], c5[0], c5[1], c5[2], c5[3]},
                            kac[8] = {c6[0], c6[1], c6[2], c6[3], c7[0], c7[1], c7[2], c7[3]}, rkc[8] = {c8_[0], c8_[1], c8_[2], c8_[3], c9[0], c9[1], c9[2], c9[3]};
                float ssq = 0.f, asg[8];
#pragma unroll
                for (int j = 0; j < 8; ++j) {
                    asg[j] = sigmoidf_(a0v[j] + alv[j]);
                    a8[j] = k8[j] * kkc[j]; ssq += a8[j] * a8[j]; }
                ssq = reduce8(ssq);
                const float inv = 1.0f / fmaxf(sqrtf(ssq), 1e-12f);
                float bon = 0.f;
#pragma unroll
                for (int j = 0; j < 8; ++j) { const float kkn = a8[j] * inv; k8[j] = k8[j] * (1.0f + (asg[j] - 1.0f) * kac[j]); b8[j] = kkn * asg[j]; a8[j] = -kkn; bon += r8[j] * k8[j] * rkc[j]; }
                bonus = reduce8(bon);
                const int cc = ttz >> 5, tl = ttz & 31;
                const LAS float* cp = (const LAS float*)(L + R_LD) + ttz * 64 + 8 * cgz; const LAS float* xp = (const LAS float*)(L + R_EX) + ttz * 64 + 8 * cgz; const LAS float* cl = (const LAS float*)(L + R_LAM) + cc * 64 + 8 * cgz;
                const f32x4 q0 = *(const LAS f32x4*)cp, q1 = *(const LAS f32x4*)(cp + 4), x0 = *(const LAS f32x4*)xp, x1 = *(const LAS f32x4*)(xp + 4), e0 = *(const LAS f32x4*)cl, e1 = *(const LAS f32x4*)(cl + 4);
                const float cum[8] = {q0[0], q0[1], q0[2], q0[3], q1[0], q1[1], q1[2], q1[3]}, exc[8] = {x0[0], x0[1], x0[2], x0[3], x1[0], x1[1], x1[2], x1[3]}, lamv[8] = {e0[0], e0[1], e0[2], e0[3], e1[0], e1[1], e1[2], e1[3]};
                float at[8], rt_[8], bt[8], kt[8];
                LAS bf16* bht = (LAS bf16*)(L + R_BHT + cc * 5120); LAS bf16* kht = (LAS bf16*)(L + R_KHT + cc * 5120); LAS bf16* vt = (LAS bf16*)(L + R_VT + cc * 5120);
#pragma unroll
                for (int j = 0; j < 8; ++j) { const float em = __builtin_amdgcn_exp2f(-cum[j]), ep = __builtin_amdgcn_exp2f(cum[j]), ex = __builtin_amdgcn_exp2f(exc[j]), eh = lamv[j] * em;
                    at[j] = a8[j] * ex; rt_[j] = r8[j] * ep; bt[j] = b8[j] * em; kt[j] = k8[j] * em;
                    const int c = 8 * cgz + j;
                    bht[c * 40 + tl] = (bf16)(cvt_pk_bf16(b8[j] * eh, 0.f) & 0xffffu); kht[c * 40 + tl] = (bf16)(cvt_pk_bf16(k8[j] * eh, 0.f) & 0xffffu); vt[c * 40 + tl] = (bf16)(cvt_pk_bf16(v8[j], 0.f) & 0xffffu); }
#define PK8(x) (v4u){cvt_pk_bf16(x[0], x[1]), cvt_pk_bf16(x[2], x[3]), cvt_pk_bf16(x[4], x[5]), cvt_pk_bf16(x[6], x[7])}
                const int ro = cc * 4608 + tl * 144 + cgz * 16;
                *(LAS v4u*)(L + R_AT + ro) = PK8(at); *(LAS v4u*)(L + R_RT + ro) = PK8(rt_); *(LAS v4u*)(L + R_BT + ro) = PK8(bt); *(LAS v4u*)(L + R_KT + ro) = PK8(kt);
            }
            RK_BAR();
            {
                const int cc = wave >> 2, pi = wave & 3;
                const LAS unsigned char* Ab = L + ((pi < 2) ? R_AT : R_RT) + cc * 4608 + r32z * 144 + hhz * 16;
                const LAS unsigned char* Bb = L + ((pi & 1) ? R_KT : R_BT) + cc * 4608 + r32z * 144 + hhz * 16;
                f32x16 acc = {};
#pragma unroll
                for (int s = 0; s < 4; ++s) acc = __builtin_amdgcn_mfma_f32_32x32x16_bf16(*(const LAS bf16x8*)(Ab + s * 32), *(const LAS bf16x8*)(Bb + s * 32), acc, 0, 0, 0);
                if (pi == 0) { LAS float* o = (LAS float*)(L + R_AAB) + cc * 1024;
#pragma unroll
                    for (int r = 0; r < 16; ++r) { const int t = crow(r, hhz); o[t * 32 + r32z] = (r32z < t) ? acc[r] : 0.f; } }
                else { LAS bf16* o = (LAS bf16*)(L + (pi == 1 ? R_AAK : (pi == 2 ? R_ARB : R_ARK)) + cc * 2560);
#pragma unroll
                    for (int r = 0; r < 16; ++r) { const int t = crow(r, hhz); const bool keep = (pi == 1) ? (r32z < t) : (r32z <= t); o[t * 40 + r32z] = (bf16)(cvt_pk_bf16(keep ? acc[r] : 0.f, 0.f) & 0xffffu); } }
            }
            RK_BAR();
            if (wave == 2) {
                const int cc = hhz, j = r32z; const LAS float* Ar = (const LAS float*)(L + R_AAB) + cc * 1024;
                float Tr[32];
                f32x4 rw[2][8];
#define RK_ROW(t_) do { _Pragma("unroll") for (int s4_ = 0; s4_ < ((t_) + 3) / 4; ++s4_) rw[(t_) & 1][s4_] = *(const LAS f32x4*)(Ar + (t_) * 32 + 4 * s4_); } while (0)
                RK_ROW(1);
#pragma unroll
                for (int t = 0; t < 32; ++t) { float ac[4] = {(t == j) ? 1.0f : 0.0f, 0.f, 0.f, 0.f};
                    if (t + 1 < 32 && t >= 1) RK_ROW(t + 1);
#pragma unroll
                    for (int s4 = 0; s4 < (t + 3) / 4; ++s4) { const f32x4 a4 = rw[t & 1][s4];
#pragma unroll
                        for (int q = 0; q < 4; ++q) if (4 * s4 + q < t) ac[q] += a4[q] * Tr[4 * s4 + q]; }
                    Tr[t] = (ac[0] + ac[1]) + (ac[2] + ac[3]); asm volatile("" ::: "memory"); }
#undef RK_ROW
                LAS bf16* o = (LAS bf16*)(L + R_TT + cc * 2560);
#pragma unroll
                for (int t = 0; t < 32; ++t) o[t * 40 + j] = (bf16)(cvt_pk_bf16(Tr[t], 0.f) & 0xffffu);
            } else if (wave >= 4) {
                const int cc = (wave >> 1) & 1, vt2 = wave & 1;
                const LAS unsigned char* Ab = L + R_AAK + cc * 2560 + r32z * 80 + hhz * 16; const LAS unsigned char* Bb = L + R_VT + cc * 5120 + (vt2 * 32 + r32z) * 80 + hhz * 16;
                f32x16 acc = {};
#pragma unroll
                for (int s = 0; s < 2; ++s) acc = __builtin_amdgcn_mfma_f32_32x32x16_bf16(ldsA_nat(Ab + s * 32), ldsA_nat(Bb + s * 32), acc, 0, 0, 0);
                LAS f32x4* o = (LAS f32x4*)(L + R_AKV) + (cc * 2 + vt2) * 256 + lanez;
#pragma unroll
                for (int q = 0; q < 4; ++q) o[q * 64] = (f32x4){acc[4 * q], acc[4 * q + 1], acc[4 * q + 2], acc[4 * q + 3]};
            }
            RK_BAR();
            if (wave < 2) {
#pragma unroll
                for (int cc = 0; cc < 2; ++cc) {
                    bf16x8 Hb[2][2];
#pragma unroll
                    for (int kt2 = 0; kt2 < 2; ++kt2)
#pragma unroll
                        for (int s = 0; s < 2; ++s) Hb[kt2][s] = acc_frag(Hacc[kt2], s);
                    f32x16 rhs, y = {};
                    { const LAS f32x4* ip = (const LAS f32x4*)(L + R_AKV) + (cc * 2 + wave) * 256 + lanez;
#pragma unroll
                      for (int q = 0; q < 4; ++q) { const f32x4 x = ip[q * 64]; rhs[4 * q] = x[0]; rhs[4 * q + 1] = x[1]; rhs[4 * q + 2] = x[2]; rhs[4 * q + 3] = x[3]; } }
                    const LAS unsigned char* Atb = L + R_AT + cc * 4608 + r32z * 144 + hhz * 8; const LAS unsigned char* Rtb = L + R_RT + cc * 4608 + r32z * 144 + hhz * 8;
#pragma unroll
                    for (int kt2 = 0; kt2 < 2; ++kt2)
#pragma unroll
                        for (int s = 0; s < 2; ++s) { rhs = __builtin_amdgcn_mfma_f32_32x32x16_bf16(ldsA_perm(Atb + (32 * kt2 + 16 * s) * 2), Hb[kt2][s], rhs, 0, 0, 0);
                            y = __builtin_amdgcn_mfma_f32_32x32x16_bf16(ldsA_perm(Rtb + (32 * kt2 + 16 * s) * 2), Hb[kt2][s], y, 0, 0, 0); }
                    f32x16 u = {};
                    const LAS unsigned char* Tb = L + R_TT + cc * 2560 + r32z * 80 + hhz * 8;
#pragma unroll
                    for (int s = 0; s < 2; ++s) u = __builtin_amdgcn_mfma_f32_32x32x16_bf16(ldsA_perm(Tb + 32 * s), acc_frag(rhs, s), u, 0, 0, 0);
                    bf16x8 ub[2], vb[2];
#pragma unroll
                    for (int s = 0; s < 2; ++s) { ub[s] = acc_frag(u, s); vb[s] = ldsA_nat(L + R_VT + cc * 5120 + (wave * 32 + r32z) * 80 + hhz * 16 + 32 * s); }
                    const LAS unsigned char* Rbp = L + R_ARB + cc * 2560 + r32z * 80 + hhz * 8; const LAS unsigned char* Rkn = L + R_ARK + cc * 2560 + r32z * 80 + hhz * 16;
#pragma unroll
                    for (int s = 0; s < 2; ++s) { y = __builtin_amdgcn_mfma_f32_32x32x16_bf16(ldsA_perm(Rbp + 32 * s), ub[s], y, 0, 0, 0); y = __builtin_amdgcn_mfma_f32_32x32x16_bf16(ldsA_nat(Rkn + 32 * s), vb[s], y, 0, 0, 0); }
                    const LAS float* lam = (const LAS float*)(L + R_LAM) + cc * 64;
#pragma unroll
                    for (int kt2 = 0; kt2 < 2; ++kt2) {
#pragma unroll
                        for (int q = 0; q < 4; ++q) { const f32x4 l4 = *(const LAS f32x4*)(lam + 32 * kt2 + 8 * q + 4 * hhz);
                            Hacc[kt2][4 * q] *= l4[0]; Hacc[kt2][4 * q + 1] *= l4[1]; Hacc[kt2][4 * q + 2] *= l4[2]; Hacc[kt2][4 * q + 3] *= l4[3]; }
                        const LAS unsigned char* Bhp = L + R_BHT + cc * 5120 + (32 * kt2 + r32z) * 80 + hhz * 8; const LAS unsigned char* Khn = L + R_KHT + cc * 5120 + (32 * kt2 + r32z) * 80 + hhz * 16;
#pragma unroll
                        for (int s = 0; s < 2; ++s) { Hacc[kt2] = __builtin_amdgcn_mfma_f32_32x32x16_bf16(ldsA_perm(Bhp + 32 * s), ub[s], Hacc[kt2], 0, 0, 0);
                            Hacc[kt2] = __builtin_amdgcn_mfma_f32_32x32x16_bf16(ldsA_nat(Khn + 32 * s), vb[s], Hacc[kt2], 0, 0, 0); } }
                    LAS float* yo = (LAS float*)(L + R_YB) + cc * 32 * 64 + wave * 32 + r32z;
#pragma unroll
                    for (int r = 0; r < 16; ++r) yo[crow(r, hhz) * 64] = y[r];
                }
            }
            RK_BAR();
            {
                const LAS float* yp = (const LAS float*)(L + R_YB) + ttz * 64 + 8 * cgz; const LAS float* gp = (const LAS float*)(L + R_GG) + ttz * 64 + 8 * cgz;
                const f32x4 y0 = *(const LAS f32x4*)yp, y1 = *(const LAS f32x4*)(yp + 4), g0 = *(const LAS f32x4*)gp, g1 = *(const LAS f32x4*)(gp + 4);
                const LAS float* cs = (const LAS float*)(L + R_CST) + 512 + 8 * cgz;
                const f32x4 w0_ = *(const LAS f32x4*)(cs), w1_ = *(const LAS f32x4*)(cs + 4), b0_ = *(const LAS f32x4*)(cs + 64), b1_ = *(const LAS f32x4*)(cs + 68);
                const float yv[8] = {y0[0], y0[1], y0[2], y0[3], y1[0], y1[1], y1[2], y1[3]}, gv[8] = {g0[0], g0[1], g0[2], g0[3], g1[0], g1[1], g1[2], g1[3]};
                const float lw[8] = {w0_[0], w0_[1], w0_[2], w0_[3], w1_[0], w1_[1], w1_[2], w1_[3]}, lb[8] = {b0_[0], b0_[1], b0_[2], b0_[3], b1_[0], b1_[1], b1_[2], b1_[3]};
                float sm = 0.f;
#pragma unroll
                for (int j = 0; j < 8; ++j) sm += yv[j];
                const float mean = reduce8(sm) * (1.0f / 64.0f);
                float sv = 0.f;
#pragma unroll
                for (int j = 0; j < 8; ++j) { const float d = yv[j] - mean; sv += d * d; }
                const float rs = rsqrtf(reduce8(sv) * (1.0f / 64.0f) + 64e-5f);
                float o[8];
#pragma unroll
                for (int j = 0; j < 8; ++j) o[j] = ((yv[j] - mean) * rs * lw[j] + lb[j] + bonus * v8[j]) * gv[j];
                ypend = PK8(o);
            }
        }
        *(v4u*)(yr + ((size_t)b * SEQ + (SEQ - RK_T) + tt) * C_YC + ch) = ypend;
#undef RK_PREFETCH
#undef RK_BAR
#undef UNPK8
#undef PK8
        __syncthreads();
    }
    __syncthreads();
}

constexpr int AT_K = 0;
constexpr int AT_V = 55296;
constexpr int AT_LUT = 110592;
constexpr int AT_WS = AT_LUT + 768;
constexpr int AT_OST = AT_WS + 1024;
constexpr int AT_END = AT_OST + 32768;
static_assert(AT_END <= MISC_OFF && (AT_OST % 16) == 0, "attention LDS map");

__device__ __forceinline__ void p3_attn(Frame& F, const Args& A, const int nostore) {
    LAS unsigned char* L = F.lds;
    bf16* patt = (bf16*)(F.ws + WS_PATT);
    float* lse_out = (float*)(F.ws + WS_LSE);
    const float* lutg = (const float*)(F.ws + WS_LUT);
    const int tid = ((int)threadIdx.x), lane = ((int)threadIdx.x & 63), wave = F.wave, r32 = lane & 31, hh = lane >> 5;
#define AT_GEOM(U) const int b = (U) / 96, rem = (U) % 96, hd = rem >> 3, sub = rem & 7, gi = hd >> 2; const int dil = gi == 0 ? 1 : (gi == 1 ? 4 : 16); const size_t tokb = (size_t)b * SEQ; \
        int res, qw, lrow0, kbase; \
        if (gi == 0) { res = 0; kbase = 256 * sub - 128; qw = 256 * sub + 32 * wave; lrow0 = 0; } \
        else if (gi == 1) { res = sub >> 1; kbase = 256 * (sub & 1) - 128; qw = 256 * (sub & 1) + 32 * wave; lrow0 = 0; } \
        else { res = 2 * sub + (wave >> 2); kbase = 0; qw = 32 * (wave & 3); lrow0 = (wave >> 2) * 128; }
#define AT_LOADS(U) do { AT_GEOM(U); (void)lrow0; const int npass_ = gi == 2 ? 4 : 6; \
        _Pragma("unroll") for (int ps = 0; ps < 6; ++ps) { const int lr = ps * 64 + (tid >> 3); int pos, rs_; \
            if (gi == 2) { rs_ = 2 * sub + ((lr >> 7) & 1); pos = lr & 127; } else { rs_ = res; pos = kbase + lr; } \
            kq[ps] = (v4u){0u, 0u, 0u, 0u}; vq[ps] = (v4u){0u, 0u, 0u, 0u}; \
            if (ps < npass_ && pos >= 0) { const bf16* src = patt + (tokb + (size_t)pos * dil + rs_) * C_ATT + hd * 64 + (tid & 7) * 8; kq[ps] = *(const v4u*)(src + 768); vq[ps] = *(const v4u*)(src + 1536); } } \
        } while (0)
#define AT_LOADQ(U) do { AT_GEOM(U); (void)lrow0; (void)kbase; const bf16* qp_ = patt + (tokb + (size_t)(qw + r32) * dil + res) * C_ATT + hd * 64 + hh * 8; \
        _Pragma("unroll") for (int s_ = 0; s_ < 4; ++s_) qv[s_] = *(const v4u*)(qp_ + 16 * s_); } while (0)
    bf16* pend_op = patt; size_t pend_step = 0; float* pend_lp = lse_out; float pend_lse = 0.f; bool pend = false;
#define AT_FLUSH() do { const LAS bf16* stg_ = (const LAS bf16*)(L + AT_OST) + wave * 2048; \
        if (hh == 0 && !nostore) *pend_lp = pend_lse; \
        _Pragma("unroll") for (int i_ = 0; i_ < 4; ++i_) { const v4u v_ = *(const LAS v4u*)(stg_ + (i_ * 8 + (lane >> 3)) * 64 + (lane & 7) * 8); \
            if (!nostore || v_.x == 0x12345678u) *(v4u*)(pend_op + i_ * pend_step) = v_; } } while (0)
    v4u kq[6], vq[6], qv[4];
    if (F.bx < BATCH * 96) { AT_LOADS(F.bx); AT_LOADQ(F.bx); }
    for (int unit = F.bx; unit < BATCH * 96; unit += F.G) {
        AT_GEOM(unit);
        const size_t qtok = tokb + (size_t)(qw + r32) * dil + res;
        __syncthreads();
        {
            const int npass = gi == 2 ? 4 : 6;
            const int c8 = tid & 7;
            const f32x4 kg0 = *(const f32x4*)(A.in[I_KNG] + c8 * 8), kg1 = *(const f32x4*)(A.in[I_KNG] + c8 * 8 + 4);
            if (tid < 192) ((LAS float*)(L + AT_LUT))[tid] = (tid >= 32 && tid <= 160) ? lutg[hd * 132 + tid - 32] : -1e30f;
#pragma unroll
            for (int ps = 0; ps < 6; ++ps) {
                if (ps < npass) {
                    const int lr = ps * 64 + (tid >> 3);
                    float kf[8]; kf[0] = bf_lo(kq[ps].x); kf[1] = bf_hi(kq[ps].x); kf[2] = bf_lo(kq[ps].y); kf[3] = bf_hi(kq[ps].y); kf[4] = bf_lo(kq[ps].z); kf[5] = bf_hi(kq[ps].z); kf[6] = bf_lo(kq[ps].w); kf[7] = bf_hi(kq[ps].w);
                    float ss = 0.f;
#pragma unroll
                    for (int j = 0; j < 8; ++j) ss += kf[j] * kf[j];
                    ss = reduce8(ss);
                    const float rstd = rsqrtf(ss * (1.0f / 64.0f) + 1e-6f);
                    v4u ko; ko.x = cvt_pk_bf16(kf[0] * rstd * kg0[0], kf[1] * rstd * kg0[1]); ko.y = cvt_pk_bf16(kf[2] * rstd * kg0[2], kf[3] * rstd * kg0[3]);
                    ko.z = cvt_pk_bf16(kf[4] * rstd * kg1[0], kf[5] * rstd * kg1[1]); ko.w = cvt_pk_bf16(kf[6] * rstd * kg1[2], kf[7] * rstd * kg1[3]);
                    *(LAS v4u*)(L + AT_K + lr * 144 + c8 * 16) = ko;
                    *(LAS v4u*)(L + AT_V + lr * 144 + c8 * 16) = vq[ps];
                }
            }
        }
        bf16x8 qf[4];
        {
            float ss = 0.f;
#pragma unroll
            for (int s = 0; s < 4; ++s) {
                const float f0 = bf_lo(qv[s].x), f1 = bf_hi(qv[s].x), f2 = bf_lo(qv[s].y), f3 = bf_hi(qv[s].y), f4 = bf_lo(qv[s].z), f5 = bf_hi(qv[s].z), f6 = bf_lo(qv[s].w), f7 = bf_hi(qv[s].w);
                ss += (f0 * f0 + f1 * f1) + (f2 * f2 + f3 * f3) + (f4 * f4 + f5 * f5) + (f6 * f6 + f7 * f7); }
            ss += __shfl_xor(ss, 32);
            const float rstd = rsqrtf(ss * (1.0f / 64.0f) + 1e-6f) * 0.125f;
#pragma unroll
            for (int s = 0; s < 4; ++s) { const float* g = A.in[I_QNG] + 16 * s + 8 * hh; const f32x4 g0 = *(const f32x4*)g, g1 = *(const f32x4*)(g + 4);
                v4u o; o.x = cvt_pk_bf16(bf_lo(qv[s].x) * rstd * g0[0], bf_hi(qv[s].x) * rstd * g0[1]); o.y = cvt_pk_bf16(bf_lo(qv[s].y) * rstd * g0[2], bf_hi(qv[s].y) * rstd * g0[3]);
                o.z = cvt_pk_bf16(bf_lo(qv[s].z) * rstd * g1[0], bf_hi(qv[s].z) * rstd * g1[1]); o.w = cvt_pk_bf16(bf_lo(qv[s].w) * rstd * g1[2], bf_hi(qv[s].w) * rstd * g1[3]);
                qf[s] = __builtin_bit_cast(bf16x8, o); }
        }
        __syncthreads();
        if (pend) AT_FLUSH();
        const LAS float* lutl = (const LAS float*)(L + AT_LUT) + (r32 - 4 * hh);
        f32x16 p[5]; float m = -1e30f;
#pragma unroll
        for (int jt = 0; jt < 5; ++jt) {
            const int kp0 = qw - 128 + 32 * jt;
            if (kp0 >= 0) {
                const LAS unsigned char* kb = L + AT_K + (lrow0 + kp0 - kbase + r32) * 144 + hh * 16;
                f32x16 c = {};
#pragma unroll
                for (int s = 0; s < 4; ++s) c = __builtin_amdgcn_mfma_f32_32x32x16_bf16(*(const LAS bf16x8*)(kb + s * 32), qf[s], c, 0, 0, 0);
                float bz[16];
#pragma unroll
                for (int r = 0; r < 16; ++r) bz[r] = lutl[160 - 32 * jt - crow(r, 0)];
#pragma unroll
                for (int r = 0; r < 16; ++r) { const float sv = fmaxf(c[r] + bz[r], -1e30f); c[r] = sv; m = fmaxf(m, sv); }
                p[jt] = c;
            } else {
#pragma unroll
                for (int r = 0; r < 16; ++r) p[jt][r] = -1e30f;
            }
        }
        m = fmaxf(m, __shfl_xor(m, 32));
        float l = 0.f;
#pragma unroll
        for (int jt = 0; jt < 5; ++jt)
#pragma unroll
            for (int r = 0; r < 16; ++r) { const float e = __expf(p[jt][r] - m); p[jt][r] = e; l += e; }
        l += __shfl_xor(l, 32);
        v4u pwk[5][2];
#pragma unroll
        for (int jt = 0; jt < 5; ++jt)
#pragma unroll
            for (int s2 = 0; s2 < 2; ++s2) { pwk[jt][s2].x = cvt_pk_bf16(p[jt][8 * s2 + 0], p[jt][8 * s2 + 1]); pwk[jt][s2].y = cvt_pk_bf16(p[jt][8 * s2 + 2], p[jt][8 * s2 + 3]);
                pwk[jt][s2].z = cvt_pk_bf16(p[jt][8 * s2 + 4], p[jt][8 * s2 + 5]); pwk[jt][s2].w = cvt_pk_bf16(p[jt][8 * s2 + 6], p[jt][8 * s2 + 7]); }
        if (unit + F.G < BATCH * 96) { AT_LOADS(unit + F.G); AT_LOADQ(unit + F.G); }
        f32x16 o[2]; o[0] = (f32x16){}; o[1] = (f32x16){};
#pragma unroll
        for (int jt = 0; jt < 5; ++jt) {
            const int kp0 = qw - 128 + 32 * jt;
            if (kp0 >= 0) {
#pragma unroll
                for (int s2 = 0; s2 < 2; ++s2) {
                    const bf16x8 pa = __builtin_bit_cast(bf16x8, pwk[jt][s2]);
                    const int R0 = lrow0 + kp0 - kbase + 16 * s2 + 4 * hh + ((lane & 15) >> 2);
#pragma unroll
                    for (int db = 0; db < 2; ++db) {
                        const LAS unsigned char* vp = L + AT_V + R0 * 144 + (32 * db + 16 * ((lane >> 4) & 1) + 4 * (lane & 3)) * 2;
                        const v4i16_t lo = __builtin_amdgcn_ds_read_tr16_b64_v4i16((LAS v4i16_t*)vp);
                        const v4i16_t hi = __builtin_amdgcn_ds_read_tr16_b64_v4i16((LAS v4i16_t*)(vp + 8 * 144));
                        const bf16x8 vb = (bf16x8){lo[0], lo[1], lo[2], lo[3], hi[0], hi[1], hi[2], hi[3]};
                        o[db] = __builtin_amdgcn_mfma_f32_32x32x16_bf16(pa, vb, o[db], 0, 0, 0);
                    }
                }
            }
        }
        LAS float* wsf = (LAS float*)(L + AT_WS) + wave * 32;
        if (hh == 0) wsf[r32] = l;
        pend_lse = m + __logf(l); pend_lp = lse_out + qtok * 12 + hd;
        LDS_WAIT(); asm volatile("" ::: "memory");
        LAS bf16* stg = (LAS bf16*)(L + AT_OST) + wave * 2048;
#pragma unroll
        for (int r = 0; r < 16; ++r) { const int orow = crow(r, hh); const float rl = __builtin_amdgcn_rcpf(wsf[orow]);
            const unsigned w0 = cvt_pk_bf16(o[0][r] * rl, 0.f), w1 = cvt_pk_bf16(o[1][r] * rl, 0.f);
            stg[orow * 64 + r32] = (bf16)(w0 & 0xffffu); stg[orow * 64 + 32 + r32] = (bf16)(w1 & 0xffffu); }
        LDS_WAIT(); asm volatile("" ::: "memory");
        pend_op = patt + (tokb + (size_t)(qw + (lane >> 3)) * dil + res) * C_ATT + hd * 64 + (lane & 7) * 8; pend_step = (size_t)8 * dil * C_ATT; pend = true;
    }
    if (pend) AT_FLUSH();
    __syncthreads();
#undef AT_GEOM
#undef AT_LOADS
#undef AT_FLUSH
#undef AT_LOADQ
}

__device__ __forceinline__ void p4_merge(Frame& F) {
    const bf16* og = (const bf16*)(F.ws + WS_PATT); const float* lse = (const float*)(F.ws + WS_LSE); bf16* ya = (bf16*)(F.dout + DO_YR) + 512;
    for (size_t i = (size_t)F.bx * 512 + ((int)threadIdx.x); i < (size_t)NTOK * 32; i += (size_t)F.G * 512) {
        const size_t tok = i >> 5; const int c = (int)(i & 31), j = c >> 3;
        const float l0 = lse[tok * 12 + j], l1 = lse[tok * 12 + 4 + j], l2 = lse[tok * 12 + 8 + j];
        const float mx = fmaxf(l0, fmaxf(l1, l2)); float a0 = __expf(l0 - mx), a1 = __expf(l1 - mx), a2 = __expf(l2 - mx); const float inv = 1.0f / (a0 + a1 + a2); a0 *= inv; a1 *= inv; a2 *= inv;
        const bf16* p = og + tok * C_ATT + c * 8;
        const v4u x0 = *(const v4u*)(p), x1 = *(const v4u*)(p + 256), x2 = *(const v4u*)(p + 512);
        v4u o;
        o.x = cvt_pk_bf16(a0 * bf_lo(x0.x) + a1 * bf_lo(x1.x) + a2 * bf_lo(x2.x), a0 * bf_hi(x0.x) + a1 * bf_hi(x1.x) + a2 * bf_hi(x2.x));
        o.y = cvt_pk_bf16(a0 * bf_lo(x0.y) + a1 * bf_lo(x1.y) + a2 * bf_lo(x2.y), a0 * bf_hi(x0.y) + a1 * bf_hi(x1.y) + a2 * bf_hi(x2.y));
        o.z = cvt_pk_bf16(a0 * bf_lo(x0.z) + a1 * bf_lo(x1.z) + a2 * bf_lo(x2.z), a0 * bf_hi(x0.z) + a1 * bf_hi(x1.z) + a2 * bf_hi(x2.z));
        o.w = cvt_pk_bf16(a0 * bf_lo(x0.w) + a1 * bf_lo(x1.w) + a2 * bf_lo(x2.w), a0 * bf_hi(x0.w) + a1 * bf_hi(x1.w) + a2 * bf_hi(x2.w));
        *(v4u*)(ya + tok * C_YC + c * 8) = o;
    }
}

constexpr int RT_WH = 0;
constexpr int RT_WL = 66048;
constexpr int RT_CB = 132096;
constexpr int RT_PS = RT_CB + 128;
constexpr int RT_RS = RT_PS + 2048;
constexpr int RT_LCNT = RT_RS + 1024;
constexpr int RT_LBASE = RT_LCNT + 128;
constexpr int RT_REC = RT_LBASE + 128;
static_assert(RT_REC + 4096 <= MISC_OFF, "router LDS map");
__device__ __forceinline__ void p7_route(Frame& F, const Args& A) {
    LAS unsigned char* L = F.lds;
    const float* mod = (const float*)(F.ws + WS_MOD);
    const bf16* x1 = (const bf16*)(F.ws + WS_X1);
    unsigned char* H2 = (unsigned char*)(F.ws + WS_H2);
    float* gates = (float*)(F.ws + WS_GATES); unsigned* tslot = (unsigned*)(F.ws + WS_TSLOT); int* list = (int*)(F.ws + WS_LIST);
    unsigned* gcnt = F.ctl + CW_CNT;
    const int tid = ((int)threadIdx.x), lane = ((int)threadIdx.x & 63), wave = F.wave, r32 = lane & 31, hh = lane >> 5;
    for (int blk = F.bx; blk < NTOK / 256; blk += F.G) {
        const int b = blk >> 3; const float* md = mod + (size_t)b * 6144;
        __syncthreads();
        for (int i = tid; i < 1024 * 32; i += 512) { const int k = i >> 5, e = i & 31;
            const float w = A.in[I_RTW][i] * (A.in[I_N2G][k] * (md[4096 + k] + 1.0f));
            const unsigned hi = cvt_pk_bf16(w, 0.f) & 0xffffu; const float lo = w - __uint_as_float(hi << 16);
            *(LAS bf16*)(L + RT_WH + e * 2064 + k * 2) = (bf16)hi; *(LAS bf16*)(L + RT_WL + e * 2064 + k * 2) = (bf16)(cvt_pk_bf16(lo, 0.f) & 0xffffu); }
        { const int e = tid & 31, part = tid >> 5; float s = 0.f;
          for (int k = part * 64; k < part * 64 + 64; ++k) s += md[3072 + k] * A.in[I_RTW][k * 32 + e];
          ((LAS float*)(L + RT_PS))[part * 32 + e] = s; }
        if (tid < 32) ((LAS int*)(L + RT_LCNT))[tid] = 0;
        __syncthreads();
        if (tid < 32) { float s = A.in[I_RTB][tid];
#pragma unroll
            for (int p = 0; p < 16; ++p) s += ((LAS float*)(L + RT_PS))[p * 32 + tid];
            ((LAS float*)(L + RT_CB))[tid] = s; }
        __syncthreads();
        const size_t rbase = (size_t)blk * 256 + wave * 32;
        f32x16 acc = {}; float ss = 0.f;
        {
            const bf16* xp = x1 + (rbase + r32) * D + 8 * hh;
            const LAS unsigned char* wh = L + RT_WH + r32 * 2064 + hh * 16; const LAS unsigned char* wl = L + RT_WL + r32 * 2064 + hh * 16;
            for (int s0 = 0; s0 < 64; s0 += 16) { v4u ab[16];
#pragma unroll
              for (int q = 0; q < 16; ++q) ab[q] = *(const v4u*)(xp + 16 * (s0 + q));
              asm volatile("" ::: "memory");
#pragma unroll
              for (int q = 0; q < 16; ++q) { const int s = s0 + q;
                const v4u a = ab[q];
                const float f0 = bf_lo(a.x), f1 = bf_hi(a.x), f2 = bf_lo(a.y), f3 = bf_hi(a.y), f4 = bf_lo(a.z), f5 = bf_hi(a.z), f6 = bf_lo(a.w), f7 = bf_hi(a.w);
                ss += (f0 * f0 + f1 * f1) + (f2 * f2 + f3 * f3) + (f4 * f4 + f5 * f5) + (f6 * f6 + f7 * f7);
                const bf16x8 af = __builtin_bit_cast(bf16x8, a);
                acc = __builtin_amdgcn_mfma_f32_32x32x16_bf16(af, *(const LAS bf16x8*)(wh + 32 * s), acc, 0, 0, 0);
                acc = __builtin_amdgcn_mfma_f32_32x32x16_bf16(af, *(const LAS bf16x8*)(wl + 32 * s), acc, 0, 0, 0);
              } }
        }
        ss += __shfl_xor(ss, 32);
        const float rstd_own = rsqrtf(ss * (1.0f / D) + 1e-6f);
        LAS float* rs = (LAS float*)(L + RT_RS) + wave * 32;
        if (hh == 0) rs[r32] = rstd_own;
        LDS_WAIT(); asm volatile("" ::: "memory");
        const float cbe = ((const LAS float*)(L + RT_CB))[r32];
#pragma unroll
        for (int r = 0; r < 16; ++r) {
            const int rowl = crow(r, hh);
            float val = acc[r] * rs[rowl] + cbe;
            float tv[4]; int te[4];
#pragma unroll
            for (int kk = 0; kk < 4; ++kk) {
                float mx = val;
#pragma unroll
                for (int o = 1; o < 32; o <<= 1) mx = fmaxf(mx, __shfl_xor(mx, o));
                const unsigned long long bal = __ballot(val == mx);
                const unsigned mymask = hh ? (unsigned)(bal >> 32) : (unsigned)bal;
                te[kk] = __ffs((int)mymask) - 1; tv[kk] = mx;
                if (r32 == te[kk]) val = -3.0e38f;
            }
            const float e1 = __expf(tv[1] - tv[0]), e2 = __expf(tv[2] - tv[0]), e3 = __expf(tv[3] - tv[0]); const float inv = 1.0f / (1.0f + e1 + e2 + e3);
            if (r32 < 4) {
                const int kk = r32; const int e = kk == 0 ? te[0] : (kk == 1 ? te[1] : (kk == 2 ? te[2] : te[3]));
                const float g = (kk == 0 ? 1.0f : (kk == 1 ? e1 : (kk == 2 ? e2 : e3))) * inv;
                const int pos = __hip_atomic_fetch_add((LAS int*)(L + RT_LCNT) + e, 1, __ATOMIC_RELAXED, __HIP_MEMORY_SCOPE_WORKGROUP);
                ((LAS int*)(L + RT_REC))[(wave * 32 + rowl) * 4 + kk] = e | (pos << 8);
                gates[(rbase + rowl) * 4 + kk] = g;
            }
        }
        {
            f32x4 gs[4], sh[4];
#pragma unroll
            for (int j = 0; j < 4; ++j) { const int k = 4 * lane + 256 * j; const f32x4 g = *(const f32x4*)(A.in[I_N2G] + k), sc = *(const f32x4*)(md + 4096 + k); gs[j] = g * (sc + 1.0f); sh[j] = *(const f32x4*)(md + 3072 + k); }
#pragma unroll 2
            for (int rr = 0; rr < 32; ++rr) {
                const size_t row = rbase + rr; const float rstd = rs[rr];
                const v2u* xr = (const v2u*)(x1 + row * D) + lane; unsigned w4[4];
#pragma unroll
                for (int j = 0; j < 4; ++j) { const v2u xv = xr[64 * j]; const f32x4 v = (f32x4){bf_lo(xv.x), bf_hi(xv.x), bf_lo(xv.y), bf_hi(xv.y)};
                    const f32x4 y = v * rstd * gs[j] + sh[j]; w4[j] = pk4_fp8(y[0], y[1], y[2], y[3]); }
                *(v4u*)(H2 + row * D + 256 * (lane & 3) + 16 * (lane >> 2)) = quad_transpose(w4[0], w4[1], w4[2], w4[3], lane);
            }
        }
        __syncthreads();
        if (tid < 32) ((LAS int*)(L + RT_LBASE))[tid] = (int)atomicAdd(gcnt + tid, (unsigned)((LAS int*)(L + RT_LCNT))[tid]);
        __syncthreads();
        for (int i = tid; i < 1024; i += 512) { const int rec = ((LAS int*)(L + RT_REC))[i]; const int e = rec & 255, slot = ((LAS int*)(L + RT_LBASE))[e] + (rec >> 8);
            const int tok = blk * 256 + (i >> 2);
            list[(size_t)e * CAP + slot] = tok; tslot[(size_t)tok * 4 + (i & 3)] = (unsigned)e | ((unsigned)slot << 8); }
    }
    __syncthreads();
}

constexpr int MO_TPRE = 131072, MO_CNT = MO_TPRE + 256;
__device__ __forceinline__ void moe_tables(Frame& F) {
    __syncthreads();
    if (((int)threadIdx.x) == 0) { LAS int* tpre = (LAS int*)(F.lds + MO_TPRE); LAS int* cnt = (LAS int*)(F.lds + MO_CNT); int acc = 0;
        for (int e = 0; e < 32; ++e) { const int c = (int)__hip_atomic_load(F.ctl + CW_CNT + e, __ATOMIC_RELAXED, __HIP_MEMORY_SCOPE_AGENT); cnt[e] = c; tpre[e] = acc; acc += (c + 255) >> 8; }
        tpre[32] = acc; }
    __syncthreads();
}
__device__ __forceinline__ void p_combine(Frame& F, const float* b2) {
    const LAS int* tpre = (const LAS int*)(F.lds + MO_TPRE);
    const float* mod = (const float*)(F.ws + WS_MOD); const float* gates = (const float*)(F.ws + WS_GATES); const unsigned* tslot = (const unsigned*)(F.ws + WS_TSLOT);
    const unsigned char* O = (const unsigned char*)(F.ws + WS_OBUF); float* out = (float*)F.dout; const bf16* x1 = (const bf16*)(F.ws + WS_X1);
    const int gw = F.bx * 8 + F.wave, NGW = F.G * 8, lane = (int)threadIdx.x & 63;
    f32x4 gt = (f32x4){0.f, 0.f, 0.f, 0.f}; v4u ts = (v4u){0u, 0u, 0u, 0u};
    if (gw < NTOK) { gt = *(const f32x4*)(gates + (size_t)gw * 4); ts = *(const v4u*)(tslot + (size_t)gw * 4); }
    f32x4 pra[2], prb[2]; float* pop = out; bool pend = false;
    pra[0] = pra[1] = prb[0] = prb[1] = (f32x4){0.f, 0.f, 0.f, 0.f};
    for (int t = gw; t < NTOK; t += NGW) {
        const size_t tok = (size_t)t; const int b = t >> 11;
        const float* g2 = mod + (size_t)b * 6144 + 5120;
        const unsigned tsv[4] = {ts.x, ts.y, ts.z, ts.w}; const float gv[4] = {gt[0], gt[1], gt[2], gt[3]};
        v2u ov[4][2]; v4u xq[2]; f32x4 ga[2], gb[2];
#pragma unroll
        for (int kk = 0; kk < 4; ++kk) { const int e = (int)(tsv[kk] & 255u), slot = (int)(tsv[kk] >> 8); const unsigned char* orow = O + ((size_t)tpre[e] * 256 + slot) * D + 8 * lane;
            ov[kk][0] = *(const v2u*)(orow); ov[kk][1] = *(const v2u*)(orow + 512); }
#pragma unroll
        for (int hq = 0; hq < 2; ++hq) { xq[hq] = *(const v4u*)(x1 + tok * D + 512 * hq + 8 * lane); ga[hq] = *(const f32x4*)(g2 + 512 * hq + 8 * lane); gb[hq] = *(const f32x4*)(g2 + 512 * hq + 8 * lane + 4); }
        { const int tn = (t + NGW < NTOK) ? t + NGW : t; gt = *(const f32x4*)(gates + (size_t)tn * 4); ts = *(const v4u*)(tslot + (size_t)tn * 4); }
        asm volatile("" ::: "memory");
        float accv[2][8];
#pragma unroll
        for (int hq = 0; hq < 2; ++hq) {
#pragma unroll
            for (int j = 0; j < 8; ++j) accv[hq][j] = 0.f;
#pragma unroll
            for (int kk = 0; kk < 4; ++kk) { const v2u v = ov[kk][hq];
                const f32x2 p0 = __builtin_amdgcn_cvt_pk_f32_fp8((int)v.x, false), p1 = __builtin_amdgcn_cvt_pk_f32_fp8((int)v.x, true), p2 = __builtin_amdgcn_cvt_pk_f32_fp8((int)v.y, false), p3 = __builtin_amdgcn_cvt_pk_f32_fp8((int)v.y, true);
                accv[hq][0] += gv[kk] * p0[0]; accv[hq][1] += gv[kk] * p0[1]; accv[hq][2] += gv[kk] * p1[0]; accv[hq][3] += gv[kk] * p1[1];
                accv[hq][4] += gv[kk] * p2[0]; accv[hq][5] += gv[kk] * p2[1]; accv[hq][6] += gv[kk] * p3[0]; accv[hq][7] += gv[kk] * p3[1]; } }
        asm volatile("" : "+v"(gt), "+v"(ts));
        if (pend) { *(f32x4*)(pop) = pra[0]; *(f32x4*)(pop + 4) = prb[0]; *(f32x4*)(pop + 512) = pra[1]; *(f32x4*)(pop + 516) = prb[1]; }
#pragma unroll
        for (int hq = 0; hq < 2; ++hq) {
            const f32x4 xa = (f32x4){bf_lo(xq[hq].x), bf_hi(xq[hq].x), bf_lo(xq[hq].y), bf_hi(xq[hq].y)}, xb = (f32x4){bf_lo(xq[hq].z), bf_hi(xq[hq].z), bf_lo(xq[hq].w), bf_hi(xq[hq].w)};
            f32x4 ra, rb; ra[0] = xa[0] + ga[hq][0] * accv[hq][0]; ra[1] = xa[1] + ga[hq][1] * accv[hq][1]; ra[2] = xa[2] + ga[hq][2] * accv[hq][2]; ra[3] = xa[3] + ga[hq][3] * accv[hq][3];
            rb[0] = xb[0] + gb[hq][0] * accv[hq][4]; rb[1] = xb[1] + gb[hq][1] * accv[hq][5]; rb[2] = xb[2] + gb[hq][2] * accv[hq][6]; rb[3] = xb[3] + gb[hq][3] * accv[hq][7];
            pra[hq] = ra; prb[hq] = rb; }
        pop = out + tok * D + 8 * lane; pend = true;
    }
    if (pend) { *(f32x4*)(pop) = pra[0]; *(f32x4*)(pop + 4) = prb[0]; *(f32x4*)(pop + 512) = pra[1]; *(f32x4*)(pop + 516) = prb[1]; }
}

constexpr int N_PHASES = 11;
__global__ void __launch_bounds__(512, 2) hybrid_fwd(Args args) {
    extern __shared__ __attribute__((aligned(16))) unsigned char lds_raw[];
    Frame F;
    F.lds = (LAS unsigned char*)lds_raw; F.MISC = (volatile LAS unsigned*)(F.lds + MISC_OFF);
    F.wave = __builtin_amdgcn_readfirstlane(((int)threadIdx.x) >> 6);
    F.G = gridDim.x; F.bx = blockIdx.x; F.ws = args.ws; F.dout = (unsigned char*)args.out; F.ctl = (unsigned*)(args.ws + WS_CTL);
    if (((int)threadIdx.x) < 128) ((LAS unsigned*)(F.lds + MISC_OFF))[((int)threadIdx.x)] = 0u;
    __syncthreads();
    XcdBarrier bar; bar.bar = F.ctl + CW_BAR; bar.x = 0; bar.st = nullptr;
    const int lo = args.ph_lo, hi = args.ph_hi;
    if (hi - lo > 1) bar = xcd_barrier_post(F.ctl + CW_BAR, F.MISC + 8);
#ifndef PH_MASK
#define PH_MASK 0xffffffffu
#endif
#define IN(k) (((PH_MASK >> (k)) & 1u) && lo <= (k) && (k) < hi)
#define SEAM(k) do { if (IN(k) && IN((k) + 1)) xcd_barrier(bar); } while (0)
    unsigned char* ws = args.ws;

    if (IN(0)) {
#pragma unroll 1
        for (int rep = 0; rep < NREP(0); ++rep) p0_prologue(F, args); } SEAM(0);
    if (IN(1)) {
#pragma unroll 1
        for (int rep = 0; rep < NREP(1); ++rep) p1_norm(F, args); } SEAM(1);
    if (IN(2)) {
#pragma unroll 1
        for (int rep = 0; rep < NREP(2); ++rep) {
        pg8::DenseOrder S; S.init(F.dout + DO_H, ws + WS_WEXT, NTOK, NEXT, D, F.G, F.bx); S.rb = D;
        pg8::EpiProj E{(bf16*)(ws + WS_PRKV), (bf16*)(ws + WS_PATT), (unsigned char*)(ws + WS_PGATE), (bf16*)(F.dout + DO_PLORA)};
        { const int sg = (F.bx >> 3) & 3;
#pragma unroll 1
          for (int i = 0; i < sg; ++i) { __builtin_amdgcn_s_sleep(127); __builtin_amdgcn_s_sleep(40); } }
        pg8::gemm_phase<pg8::EpiProj, pg8::DenseOrder, false, true>(F.lds, S, E); }
    } SEAM(2);
    if (IN(3)) {
#pragma unroll 1
        for (int rep = 0; rep < NREP(3); ++rep) p3_rwkv(F, args);
#pragma unroll 1
        for (int rep = 0; rep < NREP(16); ++rep) p3_attn(F, args, rep); } SEAM(3);
    if (IN(4)) {
#pragma unroll 1
        for (int rep = 0; rep < NREP(4); ++rep) p4_merge(F); } SEAM(4);
    if (IN(5)) {
#pragma unroll 1
      for (int rep = 0; rep < NREP(5); ++rep) {
        { pg8::SegOrder S; S.init(F.dout + DO_YR, ws + WS_WBRR, NTOK, D, F.G, F.bx);
          pg8::EpiMixF E{(bf16*)(ws + WS_MIXED), (const unsigned char*)(ws + WS_PGATE)};
          pg8::gemm_phase<pg8::EpiMixF, pg8::SegOrder, false>(F.lds, S, E); }
      }
    } SEAM(5);
    if (IN(6)) {
#pragma unroll 1
      for (int rep = 0; rep < NREP(6); ++rep) {
        pg8::DenseOrder S; S.init(ws + WS_MIXED, ws + WS_WOUT, NTOK, D, D, F.G, F.bx);
        pg8::EpiOut E{args.in[I_X], (bf16*)(ws + WS_X1), (const float*)(ws + WS_MOD)};
        pg8::gemm_phase<pg8::EpiOut, pg8::DenseOrder, false>(F.lds, S, E); }
    } SEAM(6);
    if (IN(7)) { p7_route(F, args); } SEAM(7);
    if (IN(8)) {
#pragma unroll 1
        for (int rep = 0; rep < NREP(8); ++rep) { moe_tables(F);
        pg8::MoeOrder S; S.A = (const char*)(ws + WS_H2); S.Bt = (const char*)(ws + WS_W1T); S.K = D; S.rb = D; S.ncol = 8; S.G = F.G; S.c = F.bx; S.bstride = (size_t)2048 * 1024;
        S.tpre = (const LAS int*)(F.lds + MO_TPRE); S.cnt = (const LAS int*)(F.lds + MO_CNT); S.list = (const int*)(ws + WS_LIST); S.nunits = S.tpre[32] * 8;
        pg8::EpiSwiglu E{(unsigned char*)(ws + WS_ACT), (const float*)(ws + WS_B1P)};
        pg8::gemm_phase<pg8::EpiSwiglu, pg8::MoeOrder, true, true>(F.lds, S, E); } } SEAM(8);
    if (IN(9)) {
#pragma unroll 1
        for (int rep = 0; rep < NREP(9); ++rep) { moe_tables(F);
        pg8::MoeOrder S; S.A = (const char*)(ws + WS_ACT); S.Bt = (const char*)(ws + WS_W2E); S.K = D; S.rb = D; S.ncol = 4; S.G = F.G; S.c = F.bx; S.bstride = (size_t)1024 * 1024;
        S.tpre = (const LAS int*)(F.lds + MO_TPRE); S.cnt = (const LAS int*)(F.lds + MO_CNT); S.list = nullptr; S.nunits = S.tpre[32] * 4;
        pg8::EpiDown E{(unsigned char*)(ws + WS_OBUF), args.in[I_EB2]};
        pg8::gemm_phase<pg8::EpiDown, pg8::MoeOrder, false, true>(F.lds, S, E); } } SEAM(9);
    if (IN(10)) { moe_tables(F); p_combine(F, args.in[I_EB2]); }
#undef IN
#undef SEAM
}

extern "C" void kernel_launch(void* const* d_in, const int* in_sizes, int n_in, void* d_out, int out_size, void* d_ws, size_t ws_size, hipStream_t stream) {
    static int grid = 0;
    if (grid == 0) {
        if (n_in != 34 || out_size != NTOK * D || ws_size < WS_END) { fprintf(stderr, "kernel_launch: unexpected shapes (n_in %d, out %d, ws %zu)\n", n_in, out_size, ws_size); grid = -1; return; }
        int dev = 0, cus = 0, per_cu = 0;
        if (hipGetDevice(&dev) != hipSuccess || hipDeviceGetAttribute(&cus, hipDeviceAttributeMultiprocessorCount, dev) != hipSuccess) { grid = -1; return; }
        if (hipFuncSetAttribute((const void*)hybrid_fwd, hipFuncAttributeMaxDynamicSharedMemorySize, LDS_BYTES) != hipSuccess) { fprintf(stderr, "kernel_launch: hipFuncSetAttribute failed\n"); grid = -1; return; }
        if (hipOccupancyMaxActiveBlocksPerMultiprocessor(&per_cu, (const void*)hybrid_fwd, 512, LDS_BYTES) != hipSuccess || per_cu < 1) fprintf(stderr, "kernel_launch: occupancy query says %d\n", per_cu);
        (void)hipGetLastError();
        grid = cus;
    }
    if (grid < 0) return;
    (void)hipMemsetAsync((char*)d_ws + WS_CTL, 0, CTL_ZERO_BYTES, stream);
    Args a{};
    for (int i = 0; i < 34; ++i) a.in[i] = (const float*)d_in[i];
    a.out = (float*)d_out; a.ws = (unsigned char*)d_ws;
#if MK_N_LAUNCHES == 1
    a.ph_lo = 0; a.ph_hi = N_PHASES;
    hipLaunchKernelGGL(hybrid_fwd, dim3(grid), dim3(512), LDS_BYTES, stream, a);
#else
    for (int p = 0; p < N_PHASES; ++p) { a.ph_lo = p; a.ph_hi = p + 1; hipLaunchKernelGGL(hybrid_fwd, dim3(grid), dim3(512), LDS_BYTES, stream, a); }
#endif
}
```

```cpp
#include <hip/hip_runtime.h>
#include <cstdio>
#include <cstdint>

#ifndef MK_N_LAUNCHES
#define MK_N_LAUNCHES 1
#endif

#ifndef PROBE_DUP
#define PROBE_DUP 0u
#endif
#define NREP(k) ((((PROBE_DUP) >> (k)) & 1u) ? 2 : 1)
#define GAS __attribute__((address_space(1)))
#define LAS __attribute__((address_space(3)))
typedef unsigned short bf16;
typedef unsigned v4u __attribute__((ext_vector_type(4)));
typedef unsigned v2u __attribute__((ext_vector_type(2)));
typedef float f32x2 __attribute__((ext_vector_type(2)));
typedef float f32x4 __attribute__((ext_vector_type(4)));
typedef float f32x16 __attribute__((ext_vector_type(16)));
typedef short bf16x8 __attribute__((ext_vector_type(8)));
typedef short v4i16_t __attribute__((ext_vector_type(4)));
typedef int v8i_t __attribute__((ext_vector_type(8)));

constexpr int BATCH = 32, SEQ = 2048, D = 1024, NTOK = BATCH * SEQ;
constexpr int RW = 512, HD = 64, NEXP = 32, TOPK = 4;
constexpr int NEXT = 6400;
constexpr int C_RKV = 1536, C_ATT = 2304, C_GATE = 2048, C_LORA = 512, C_YC = 768;
constexpr int CAP = NTOK;
constexpr int MOE_ROWS = NTOK * TOPK + NEXP * 256;

constexpr size_t MiB = 1u << 20;
constexpr size_t WS_CTL = 0, CTL_ZERO_BYTES = 64 * 1024;
constexpr size_t WS_MOD = 1 * MiB;
constexpr size_t WS_LUT = WS_MOD + 768 * 1024;
constexpr size_t WS_B1P = WS_LUT + 8 * 1024;
constexpr size_t WS_WEXT = 2 * MiB + 512 * 1024;
constexpr size_t WS_WBRR = 15 * MiB;
constexpr size_t WS_WBRA = 16 * MiB;
constexpr size_t WS_WOUT = 16 * MiB + 512 * 1024;
constexpr size_t WS_W2T = 18 * MiB + 512 * 1024;
constexpr size_t WS_A2T = WS_W2T + 64 * 1024, WS_G2T = WS_A2T + 64 * 1024;
constexpr size_t WS_GATES = 19 * MiB;
constexpr size_t WS_TSLOT = 20 * MiB;
constexpr size_t WS_LIST = 21 * MiB;
constexpr size_t WS_LSE = 29 * MiB;
constexpr size_t WS_W1T = 32 * MiB;
constexpr size_t WS_W2E = 160 * MiB;
constexpr size_t WS_PRKV = 224 * MiB;
constexpr size_t WS_PGATE = 416 * MiB;
constexpr size_t WS_PATT = 672 * MiB;
constexpr size_t WS_MIXED = WS_PRKV;
constexpr size_t WS_ACT = 224 * MiB;
constexpr size_t WS_OBUF = 488 * MiB;
constexpr size_t WS_H2 = 896 * MiB;
constexpr size_t WS_X1 = 752 * MiB;
constexpr size_t WS_END = 1024 * MiB;
constexpr size_t DO_H = 0, DO_YR = 0, DO_YA = 64 * MiB, DO_PLORA = 128 * MiB;

constexpr int CW_BAR = 1024;
constexpr int CW_CNT = 8192;

constexpr int LDS_BYTES = 160 * 1024;
constexpr int MISC_OFF = LDS_BYTES - 512;
constexpr int RING_BYTES = 131072;

#define LDS_WAIT() asm volatile("s_waitcnt lgkmcnt(0)" ::: "memory")
#define VM_WAIT() asm volatile("s_waitcnt vmcnt(0)" ::: "memory")
typedef __bf16 bf16x2_t __attribute__((ext_vector_type(2)));
__device__ __forceinline__ unsigned cvt_pk_bf16(float lo, float hi) { const f32x2 v = {lo, hi}; const bf16x2_t b = __builtin_convertvector(v, bf16x2_t); return __builtin_bit_cast(unsigned, b); }
__device__ __forceinline__ unsigned pk4_fp8(float a, float b, float c, float d) { int w = __builtin_amdgcn_cvt_pk_fp8_f32(a, b, 0, false); w = __builtin_amdgcn_cvt_pk_fp8_f32(c, d, w, true); return (unsigned)w; }
__device__ __forceinline__ v4u quad_transpose(unsigned a0, unsigned a1, unsigned a2, unsigned a3, int lane) {
    const bool odd = (lane & 1) != 0, hi = (lane & 2) != 0;
    const unsigned s0 = odd ? a0 : a1, s1 = odd ? a2 : a3;
    const unsigned r0 = (unsigned)__builtin_amdgcn_mov_dpp((int)s0, 0xB1, 0xF, 0xF, true), r1 = (unsigned)__builtin_amdgcn_mov_dpp((int)s1, 0xB1, 0xF, 0xF, true);
    const unsigned c0 = odd ? r0 : a0, c1 = odd ? a1 : r0, c2 = odd ? r1 : a2, c3 = odd ? a3 : r1;
    const unsigned t0 = hi ? c0 : c2, t1 = hi ? c1 : c3;
    const unsigned q0 = (unsigned)__builtin_amdgcn_mov_dpp((int)t0, 0x4E, 0xF, 0xF, true), q1 = (unsigned)__builtin_amdgcn_mov_dpp((int)t1, 0x4E, 0xF, 0xF, true);
    return (v4u){hi ? q0 : c0, hi ? q1 : c1, hi ? c2 : q0, hi ? c3 : q1};
}
__device__ __forceinline__ float bf_lo(unsigned u) { return __uint_as_float(u << 16); }
__device__ __forceinline__ float bf_hi(unsigned u) { return __uint_as_float(u & 0xffff0000u); }
__device__ __forceinline__ float sigmoidf_(float x) { return __builtin_amdgcn_rcpf(1.0f + __expf(-x)); }
template <int CTRL> __device__ __forceinline__ float dpp_f(float v) { return __int_as_float(__builtin_amdgcn_update_dpp(0, __float_as_int(v), CTRL, 0xf, 0xf, true)); }
__device__ __forceinline__ float reduce8(float v) { v += dpp_f<0xB1>(v); v += dpp_f<0x4E>(v); v += dpp_f<0x141>(v); return v; }
__device__ __forceinline__ float reduce16(float v) { v = reduce8(v); v += dpp_f<0x140>(v); return v; }
__device__ __forceinline__ float wave_sum(float v) {
#pragma unroll
    for (int o = 1; o < 64; o <<= 1) v += __shfl_xor(v, o);
    return v;
}
__device__ __forceinline__ int crow(int r, int hi) { return (r & 3) + 8 * (r >> 2) + 4 * hi; }

#define XB_TMO      128
#define XB_XCNT(j)  (256  + 64 * (j))
#define XB_XSUB(j)  (1280 + 64 * (j))
#define XB_XGEN(j)  (2304 + 64 * (j))
#define XB_TOP      3328
#define XB_TOPGEN   3392
#define XCD_BAR_WORDS 3456
#define XB_SPIN_CAP (1u << 18)
__device__ __forceinline__ unsigned xb_ld(unsigned* p)              { return __hip_atomic_load(p, __ATOMIC_RELAXED, __HIP_MEMORY_SCOPE_AGENT); }
__device__ __forceinline__ unsigned xb_add(unsigned* p, unsigned v) { return __hip_atomic_fetch_add(p, v, __ATOMIC_RELAXED, __HIP_MEMORY_SCOPE_AGENT); }
__device__ __forceinline__ unsigned xb_xcc_id() { return (unsigned)__builtin_amdgcn_s_getreg((3 << 11) | 20) & 0xFu; }
#define XB_SPIN(cond, bar) do { unsigned _sp = 0; while (cond) { __builtin_amdgcn_s_sleep(1); \
    if ((++_sp & 255u) == 0u) { if (xb_ld(&(bar)[XB_TMO])) break; if (_sp > XB_SPIN_CAP) { atomicAdd(&(bar)[XB_TMO], 1u); break; } } } } while (0)
struct XcdBarrier { unsigned* bar; unsigned x; volatile LAS unsigned* st; };
__device__ __forceinline__ XcdBarrier xcd_barrier_post(unsigned* bar, volatile LAS unsigned* st) {
    XcdBarrier b; b.bar = bar; b.x = xb_xcc_id(); b.st = st;
    if (threadIdx.x == 0) (void)xb_add(&bar[XB_XCNT(b.x)], 1u);
    return b;
}
__device__ __forceinline__ void xcd_barrier_complete(unsigned* bar, unsigned x, unsigned& nloc, unsigned& nx) {
    const unsigned G = gridDim.x * gridDim.y * gridDim.z;
    unsigned sum, cnt, mine, sp = 0u;
    for (;;) {
        sum = 0u; cnt = 0u; mine = 0u;
#pragma unroll
        for (unsigned j = 0; j < 16; ++j) { const unsigned c = xb_ld(&bar[XB_XCNT(j)]); sum += c; cnt += (c > 0u) ? 1u : 0u; mine = (j == x) ? c : mine; }
        if (sum == G) break;
        __builtin_amdgcn_s_sleep(1);
        if ((++sp & 255u) == 0u) { if (xb_ld(&bar[XB_TMO])) break; if (sp > XB_SPIN_CAP) { atomicAdd(&bar[XB_TMO], 1u); break; } }
    }
    nloc = mine > 0u ? mine : 1u; nx = cnt > 0u ? cnt : 1u;
}
__device__ __forceinline__ void xcd_barrier(const XcdBarrier& b) {
    asm volatile("s_waitcnt vmcnt(0)" ::: "memory");
    __syncthreads();
    if (threadIdx.x == 0) {
        unsigned* bar = b.bar;
        __builtin_amdgcn_s_waitcnt(0);
        unsigned nloc = b.st[0], nx = b.st[1];
        if (nloc == 0u) { xcd_barrier_complete(bar, b.x, nloc, nx); b.st[0] = nloc; b.st[1] = nx; }
        const unsigned old = xb_add(&bar[XB_XSUB(b.x)], 1u);
        const unsigned gen = old / nloc;
        if (old + 1u == (gen + 1u) * nloc) {
            __builtin_amdgcn_fence(__ATOMIC_RELEASE, "agent");
            asm volatile("s_waitcnt vmcnt(0)" ::: "memory");
            const unsigned og = xb_add(&bar[XB_TOP], 1u);
            const unsigned tg = og / nx;
            if (og + 1u == (tg + 1u) * nx) xb_add(&bar[XB_TOPGEN], 1u);
            else XB_SPIN(xb_ld(&bar[XB_TOPGEN]) == tg, bar);
            __builtin_amdgcn_fence(__ATOMIC_ACQUIRE, "agent");
            xb_add(&bar[XB_XGEN(b.x)], 1u);
            asm volatile("s_waitcnt vmcnt(0)" ::: "memory");
        } else {
            XB_SPIN(xb_ld(&bar[XB_XGEN(b.x)]) == gen, bar);
            __builtin_amdgcn_fence(__ATOMIC_ACQUIRE, "agent");
            asm volatile("s_waitcnt vmcnt(0)" ::: "memory");
        }
    }
    __syncthreads();
}

namespace pg8 {
constexpr int BM = 256, BK = 64, HALF = 128, HTB = HALF * BK * 2, NXCD = 8;
__host__ __device__ __forceinline__ int lds_byte(int r, int c) { const int st = (r >> 4) * 2 + (c >> 5), rr = r & 15, cc = c & 31, ob = rr * 64 + cc * 2; return st * 1024 + (ob ^ (((ob >> 9) & 1) << 5)); }
__host__ __device__ __forceinline__ void stage_rc(int b, int& R, int& C) { const int st = b / 1024, sb = b % 1024, swz = sb ^ (((sb >> 9) & 1) << 5); R = (st >> 1) * 16 + swz / 64; C = (st & 1) * 32 + (swz % 64) / 2; }
__host__ __device__ __forceinline__ int perm32(int rho) { const int n = rho >> 4, i = rho & 15; return 8 * (i >> 2) + 4 * n + (i & 3); }

struct Unit { int pm, pn, e, aux; };

struct DenseOrder {
    static constexpr bool SEG = false;
    const char* A; const char* Bt; int K, rb, nM, nN, nwg, G, c;
    __device__ __forceinline__ void init(const void* A_, const void* Bt_, int M, int N, int K_, int G_, int c_) { A = (const char*)A_; Bt = (const char*)Bt_; K = K_; rb = K_ * 2; nM = M / BM; nN = N / BM; nwg = nM * nN; G = G_; c = c_; }
    __device__ __forceinline__ bool next(int i, Unit& u) const {
        const long L = (long)i * G + c; if (L >= nwg) return false;
        int wgid = (int)L; { const int q = nwg / NXCD, r = nwg % NXCD, xcd = wgid % NXCD, off = wgid / NXCD; wgid = (xcd < r ? xcd * (q + 1) : r * (q + 1) + (xcd - r) * q) + off; }
        const int nig = 8 * nN, gid = wgid / nig, fm = gid * 8, gsz = (nM - fm) < 8 ? (nM - fm) : 8;
        u.pm = fm + ((wgid % nig) % gsz); u.pn = (wgid % nig) / gsz; u.e = 0; u.aux = 256; return true;
    }
    __device__ __forceinline__ unsigned A0(const Unit& u) const { return (unsigned)u.pm * 256u * (unsigned)rb; }
    __device__ __forceinline__ unsigned B0(const Unit& u) const { return (unsigned)u.pn * 256u * (unsigned)rb; }
    __device__ __forceinline__ const int* rows(const Unit&) const { return nullptr; }
    __device__ __forceinline__ const int* rows_base() const { return nullptr; }
    __device__ __forceinline__ unsigned rows_off(const Unit&) const { return 0u; }
};
struct SegOrder {
    static constexpr bool SEG = true;
    const char* A; const char* Bt; int rb, nM, nN, nwg, G, c;
    __device__ __forceinline__ void init(const void* A_, const void* Bt_, int M, int N, int G_, int c_) { A = (const char*)A_; Bt = (const char*)Bt_; rb = 768 * 2; nM = M / BM; nN = N / BM; nwg = nM * nN; G = G_; c = c_; }
    __device__ __forceinline__ bool next(int i, Unit& u) const {
        const long L = (long)(i >> 1) * G + c; if (L >= nwg) return false;
        int wgid = (int)L; { const int q = nwg / NXCD, r = nwg % NXCD, xcd = wgid % NXCD, off = wgid / NXCD; wgid = (xcd < r ? xcd * (q + 1) : r * (q + 1) + (xcd - r) * q) + off; }
        const int nig = 8 * nN, gid = wgid / nig, fm = gid * 8, gsz = (nM - fm) < 8 ? (nM - fm) : 8;
        u.pm = fm + ((wgid % nig) % gsz); u.pn = (wgid % nig) / gsz; u.e = i & 1; u.aux = 256; return true;
    }
    __device__ __forceinline__ int nt_of(const Unit& u) const { return u.e ? 4 : 8; }
    __device__ __forceinline__ unsigned A0(const Unit& u) const { return (unsigned)u.pm * 256u * (unsigned)rb + (u.e ? 1024u : 0u); }
    __device__ __forceinline__ unsigned B0(const Unit& u) const { return (unsigned)u.pn * 256u * (unsigned)rb + (u.e ? 1024u : 0u); }
    __device__ __forceinline__ const int* rows(const Unit&) const { return nullptr; }
    __device__ __forceinline__ const int* rows_base() const { return nullptr; }
    __device__ __forceinline__ unsigned rows_off(const Unit&) const { return 0u; }
};
struct MoeOrder {
    static constexpr bool SEG = false;
    const char* A; const char* Bt; int K, rb, ncol, nunits, G, c; size_t bstride;
    const LAS int* tpre;
    const LAS int* cnt;
    const int* list;
    __device__ __forceinline__ bool next(int i, Unit& u) const {
        const long L = (long)i * G + c; if (L >= nunits) return false;
        int wgid = (int)L; { const int q = nunits / NXCD, r = nunits % NXCD, xcd = wgid % NXCD, off = wgid / NXCD; wgid = (xcd < r ? xcd * (q + 1) : r * (q + 1) + (xcd - r) * q) + off; }
        const int gt = wgid / ncol;
        int e = 0;
#pragma unroll 1
        for (int s = 16; s >= 1; s >>= 1) { if (tpre[e + s] * ncol <= wgid) e += s; }
        (void)gt;
        const int ul = wgid - tpre[e] * ncol, nt = tpre[e + 1] - tpre[e];
        const int nig = 4 * ncol, gid = ul / nig, fm = gid * 4, gsz = (nt - fm) < 4 ? (nt - fm) : 4;
        const int rt = fm + ((ul % nig) % gsz);
        u.pn = __builtin_amdgcn_readfirstlane((ul % nig) / gsz); u.e = __builtin_amdgcn_readfirstlane(e); u.pm = __builtin_amdgcn_readfirstlane(tpre[e] + rt);
        const int left = cnt[e] - rt * 256; u.aux = __builtin_amdgcn_readfirstlane(left < 256 ? left : 256);
        return true;
    }
    __device__ __forceinline__ unsigned A0(const Unit& u) const { return (unsigned)u.pm * 256u * (unsigned)rb; }
    __device__ __forceinline__ unsigned B0(const Unit& u) const { return (unsigned)u.e * (unsigned)bstride + (unsigned)u.pn * 256u * (unsigned)rb; }
    __device__ __forceinline__ const int* rows(const Unit& u) const { return list + (size_t)u.e * CAP + (size_t)(u.pm - tpre[u.e]) * 256; }
    __device__ __forceinline__ const int* rows_base() const { return list; }
    __device__ __forceinline__ unsigned rows_off(const Unit& u) const { return (unsigned)__builtin_amdgcn_readfirstlane((u.e * CAP + (u.pm - tpre[u.e]) * 256) * 4); }
};

__device__ __forceinline__ void mfma_fp8_acc(f32x4& c, const v8i_t a, const v8i_t b, const int sa, const int sb) {
    asm volatile("v_mfma_scale_f32_16x16x128_f8f6f4 %0, %1, %2, %0, %3, %4 op_sel_hi:[0,0,0]" : "+v"(c) : "v"(a), "v"(b), "v"(sa), "v"(sb));
}
__device__ __forceinline__ void mfma_bf16_acc(f32x4& c, const bf16x8 a, const bf16x8 b) {
    asm volatile("v_mfma_f32_16x16x32_bf16 %0, %1, %2, %0" : "+v"(c) : "v"(a), "v"(b));
}
#define PG8_MFMA_DRAIN() asm volatile("s_nop 15\n\ts_nop 15" : "+v"(acc[1][1][3][1]), "+v"(acc[1][1][3][0]), "+v"(acc[1][1][2][1]), "+v"(acc[1][1][2][0]) :: "memory")
template <class Epi, class Sched, bool GATHER, bool FP8 = false>
__device__ __forceinline__ void gemm_phase(LAS unsigned char* lds, const Sched& S, const Epi& E) {
    const int tid = threadIdx.x, wid = __builtin_amdgcn_readfirstlane(tid >> 6), lane = tid & 63, wr = wid >> 2, wc = wid & 3, fr = lane & 15, fq = lane >> 4;
    const int RBy = S.rb; int nt = RBy / 128;
    const __amdgpu_buffer_rsrc_t rsA = __builtin_amdgcn_make_buffer_rsrc((void*)S.A, 0, 0x7fffffff, 0x00020000);
    const __amdgpu_buffer_rsrc_t rsB = __builtin_amdgcn_make_buffer_rsrc((void*)S.Bt, 0, 0x7fffffff, 0x00020000);
    constexpr bool AUX = Epi::AUX;
    constexpr int AUX_IDS = RING_BYTES + 1024, AUX_BIAS = RING_BYTES + 3072;
    const void* lbase_ = S.A; const void* bbase_ = S.A;
    if constexpr (AUX) { lbase_ = S.rows_base(); bbase_ = E.bias_base(); }
    const __amdgpu_buffer_rsrc_t rsL = __builtin_amdgcn_make_buffer_rsrc((void*)lbase_, 0, 0x7fffffff, 0x00020000);
    const __amdgpu_buffer_rsrc_t rsBi = __builtin_amdgcn_make_buffer_rsrc((void*)bbase_, 0, 0x7fffffff, 0x00020000);
    int voffB[2], voffA0[2], voffA1[2];
#pragma unroll
    for (int i = 0; i < 2; ++i) { int R, C; stage_rc(tid * 16 + i * 8192, R, C); const int Rb = Epi::PERM ? ((R & ~31) + perm32(R & 31)) : R;
        voffA0[i] = R * RBy + C * 2; voffA1[i] = voffA0[i]; voffB[i] = Rb * RBy + C * 2; }
    const unsigned kstep = 128u;
    const unsigned hstep = (unsigned)HALF * (unsigned)RBy;
    const unsigned ahstep = GATHER ? 0u : hstep;
    const unsigned ldsw = (unsigned)wid * 1024u;
    const int aoff = lds_byte(wr * 64 + fr, fq * 8), boff = lds_byte(wc * 32 + fr, fq * 8);
#define PG8_SA(b, h) (((b) * 2 + (h)) * HTB)
#define PG8_SB(b, h) ((4 + (b) * 2 + (h)) * HTB)
#define PG8_STAGE(rs, bufoff, soff, voff) do { _Pragma("unroll") for (int _i = 0; _i < 2; ++_i) \
        __builtin_amdgcn_raw_ptr_buffer_load_lds(rs, (LAS void*)(lds + (bufoff) + ldsw + _i * 8192), 16, (voff)[_i], (int)(soff), 0, 0); } while (0)
#define PG8_LDA(dst, b, h) do { _Pragma("unroll") for (int m = 0; m < 4; ++m) _Pragma("unroll") for (int k = 0; k < 2; ++k) dst[m][k] = *(const LAS bf16x8*)(lds + PG8_SA(b, h) + aoff + m * 2048 + k * 1024); } while (0)
#define PG8_LDB(dst, b, h) do { _Pragma("unroll") for (int n = 0; n < 2; ++n) _Pragma("unroll") for (int k = 0; k < 2; ++k) dst[n][k] = *(const LAS bf16x8*)(lds + PG8_SB(b, h) + boff + n * 2048 + k * 1024); } while (0)
#define PG8_CAT(x) __builtin_bit_cast(v8i_t, __builtin_shufflevector(x[0], x[1], 0, 1, 2, 3, 4, 5, 6, 7, 8, 9, 10, 11, 12, 13, 14, 15))
#define PG8_MMA(ai, bj, At, Bt) do { __builtin_amdgcn_s_setprio(1); \
        if constexpr (FP8) { _Pragma("unroll") for (int m = 0; m < 4; ++m) _Pragma("unroll") for (int n = 0; n < 2; ++n) \
            mfma_fp8_acc(acc[ai][bj][m][n], PG8_CAT(Bt[n]), PG8_CAT(At[m]), sclW, sclA); } \
        else if constexpr (true) { _Pragma("unroll") for (int k = 0; k < 2; ++k) _Pragma("unroll") for (int m = 0; m < 4; ++m) _Pragma("unroll") for (int n = 0; n < 2; ++n) \
            mfma_bf16_acc(acc[ai][bj][m][n], Bt[n][k], At[m][k]); }        \
        else { _Pragma("unroll") for (int m = 0; m < 4; ++m) _Pragma("unroll") for (int n = 0; n < 2; ++n) _Pragma("unroll") for (int k = 0; k < 2; ++k) \
            acc[ai][bj][m][n] = __builtin_amdgcn_mfma_f32_16x16x32_bf16(Bt[n][k], At[m][k], acc[ai][bj][m][n], 0, 0, 0); } \
        __builtin_amdgcn_s_setprio(0); } while (0)
#define PG8_WAIT_V(n) asm volatile("s_waitcnt vmcnt(" #n ")" ::: "memory")
#define PG8_WAIT_VX() asm volatile("s_waitcnt vmcnt(%0)" :: "i"((8 + Epi::NVM) > 63 ? 63 : (8 + Epi::NVM)) : "memory")
#define PG8_WAIT_L(n) asm volatile("s_waitcnt lgkmcnt(" #n ")" ::: "memory")
#define PG8_BAR __builtin_amdgcn_s_barrier()
#define PG8_SCHED __builtin_amdgcn_sched_barrier(0)
#define PG8_TRIP(WAITX) do { \
            const bool last = (t == nt - 2); \
            const unsigned a1 = cA + (unsigned)(t + 1) * kstep; \
            const unsigned a2 = last ? nA : cA + (unsigned)(t + 2) * kstep, b2 = last ? nB : cB + (unsigned)(t + 2) * kstep; \
            const unsigned a3 = a2 + kstep, b3 = b2 + kstep; \
            int nx0[2] = {0, 0}, nx1[2] = {0, 0}; \
            if constexpr (AUX) { if (t == nt - 4 && has_next) { const int sl_ = ((ui + 1) & 1) * 1024; \
                if constexpr (GATHER) __builtin_amdgcn_raw_ptr_buffer_load_lds(rsL, (LAS void*)(lds + AUX_IDS + sl_), 16, lane * 16, (int)S.rows_off(nxt), 0, 0); \
                __builtin_amdgcn_raw_ptr_buffer_load_lds(rsBi, (LAS void*)(lds + AUX_BIAS + sl_), 16, lane * 16, (int)E.bias_off(nxt), 0, 0); } } \
            if constexpr (GATHER) { if (last && has_next) { if constexpr (AUX) PG8_GATHER_OFFS_LDS(nxt, ((ui + 1) & 1) * 1024, nx0, nx1); else PG8_GATHER_OFFS(nxt, nx0, nx1); } } \
            PG8_LDB(B0, 0, 0); PG8_LDB(B1, 0, 1); PG8_SCHED; PG8_LDA(At, 0, 0); PG8_STAGE(rsA, PG8_SA(1, 1), a1 + ahstep, voffA1); \
            if constexpr (GATHER) { if (last && has_next) { voffA0[0] = nx0[0]; voffA0[1] = nx0[1]; voffA1[0] = nx1[0]; voffA1[1] = nx1[1]; } } \
            WAITX; \
            PG8_WAIT_L(0); PG8_BAR; PG8_MMA(0, 0, At, B0); PG8_MMA(0, 1, At, B1); PG8_BAR; PG8_SCHED; \
            PG8_LDA(At, 0, 1); PG8_STAGE(rsB, PG8_SB(0, 0), b2, voffB); PG8_STAGE(rsB, PG8_SB(0, 1), b2 + hstep, voffB); PG8_STAGE(rsA, PG8_SA(0, 0), a2, voffA0); \
            WAITX; \
            PG8_WAIT_L(0); PG8_BAR; PG8_MMA(1, 0, At, B0); PG8_MMA(1, 1, At, B1); PG8_BAR; PG8_SCHED; \
            PG8_LDB(B0, 1, 0); PG8_LDB(B1, 1, 1); PG8_SCHED; PG8_LDA(At, 1, 0); PG8_STAGE(rsA, PG8_SA(0, 1), a2 + ahstep, voffA1); \
            PG8_WAIT_V(8); PG8_WAIT_L(0); PG8_BAR; PG8_MMA(0, 0, At, B0); PG8_MMA(0, 1, At, B1); PG8_BAR; PG8_SCHED; \
            PG8_LDA(At, 1, 1); PG8_STAGE(rsB, PG8_SB(1, 0), b3, voffB); PG8_STAGE(rsB, PG8_SB(1, 1), b3 + hstep, voffB); PG8_STAGE(rsA, PG8_SA(1, 0), a3, voffA0); \
            PG8_WAIT_V(8); PG8_WAIT_L(0); PG8_BAR; PG8_MMA(1, 0, At, B0); PG8_MMA(1, 1, At, B1); PG8_BAR; PG8_SCHED; \
        } while (0)
    int sclW = 0x7a7a7a7a, sclA = 0x7f7f7f7f; asm volatile("" : "+v"(sclW), "+v"(sclA));
    Unit cur, nxt; int ui = 0;
    if (!S.next(0, cur)) return;
    if constexpr (Sched::SEG) nt = S.nt_of(cur);
    f32x4 acc[2][2][4][2];
    if constexpr (!Epi::BINIT) {
#pragma unroll
    for (int a = 0; a < 2; ++a)
#pragma unroll
        for (int b = 0; b < 2; ++b)
#pragma unroll
            for (int m = 0; m < 4; ++m)
#pragma unroll
                for (int n = 0; n < 2; ++n) acc[a][b][m][n] = (f32x4){0.f, 0.f, 0.f, 0.f};
    }
    bf16x8 At[4][2], B0[2][2], B1[2][2];
    unsigned cA = GATHER ? 0u : S.A0(cur), cB = S.B0(cur);
#define PG8_GATHER_OFFS(u, o0, o1) do { const int* rl_ = S.rows(u); _Pragma("unroll") for (int i = 0; i < 2; ++i) { int R_, C_; stage_rc(tid * 16 + i * 8192, R_, C_); \
        const int r0_ = R_ < (u).aux ? R_ : 0, r1_ = (R_ + 128) < (u).aux ? (R_ + 128) : 0; o0[i] = rl_[r0_] * RBy + C_ * 2; o1[i] = rl_[r1_] * RBy + C_ * 2; } } while (0)
#define PG8_GATHER_OFFS_LDS(u, slb, o0, o1) do { const LAS int* il_ = (const LAS int*)(lds + AUX_IDS + (slb)); _Pragma("unroll") for (int i = 0; i < 2; ++i) { int R_, C_; stage_rc(tid * 16 + i * 8192, R_, C_); \
        const int r0_ = R_ < (u).aux ? R_ : 0, r1_ = (R_ + 128) < (u).aux ? (R_ + 128) : 0; o0[i] = il_[r0_] * RBy + C_ * 2; o1[i] = il_[r1_] * RBy + C_ * 2; } } while (0)
    if constexpr (GATHER) { PG8_GATHER_OFFS(cur, voffA0, voffA1); }
    if constexpr (AUX) { if (tid < 256) ((LAS float*)(lds + AUX_BIAS))[tid] = ((const float*)((const char*)E.bias_base() + E.bias_off(cur)))[tid]; PG8_WAIT_L(0); }
    PG8_STAGE(rsB, PG8_SB(0, 0), cB, voffB); PG8_STAGE(rsB, PG8_SB(0, 1), cB + hstep, voffB); PG8_STAGE(rsA, PG8_SA(0, 0), cA, voffA0); PG8_STAGE(rsA, PG8_SA(0, 1), cA + ahstep, voffA1);
    if (wr == 1) PG8_BAR;
    PG8_WAIT_V(2); PG8_BAR;
    if constexpr (Epi::BINIT) E.init(acc, wc, fq, (const LAS float*)(lds + AUX_BIAS));
    PG8_STAGE(rsB, PG8_SB(1, 0), cB + kstep, voffB); PG8_STAGE(rsA, PG8_SA(1, 0), cA + kstep, voffA0); PG8_STAGE(rsB, PG8_SB(1, 1), cB + hstep + kstep, voffB);
    PG8_WAIT_V(6); PG8_BAR;
#define PG8_UNIT(EPI_, REINIT_) { \
        const bool has_next = S.next(ui + 1, nxt); \
        const unsigned nA = GATHER ? 0u : (has_next ? S.A0(nxt) : cA), nB = has_next ? S.B0(nxt) : cB; \
          \
        int t = 0; \
        if (ui > 0) { PG8_TRIP(PG8_WAIT_VX()); t = 2; } \
        for (; t < nt; t += 2) { PG8_TRIP(PG8_WAIT_V(8)); } \
        if (Epi::ALIGN && wr == 0) PG8_BAR;                                         \
        PG8_MFMA_DRAIN(); \
        EPI_; \
        if (!has_next) break; \
        REINIT_; \
        cur = nxt; cA = nA; cB = nB; ++ui; \
        if constexpr (Sched::SEG) nt = S.nt_of(cur); \
        if (Epi::ALIGN && wr == 1) PG8_BAR; }
#define PG8_ZERO_ACC() do { _Pragma("unroll") for (int a = 0; a < 2; ++a) _Pragma("unroll") for (int b = 0; b < 2; ++b) _Pragma("unroll") for (int m = 0; m < 4; ++m) _Pragma("unroll") for (int n = 0; n < 2; ++n) \
        acc[a][b][m][n] = (f32x4){0.f, 0.f, 0.f, 0.f}; } while (0)
    for (;;) {
        if constexpr (Sched::SEG) {
            PG8_UNIT(E.mid(acc, cur, wr, wc, fr, fq), (void)0)
            PG8_UNIT(E(acc, cur, wr, wc, fr, fq), PG8_ZERO_ACC())
        } else if constexpr (AUX) {
            PG8_UNIT(E(acc, cur, wr, wc, fr, fq, (const LAS float*)(lds + AUX_BIAS + (ui & 1) * 1024)), E.init(acc, wc, fq, (const LAS float*)(lds + AUX_BIAS + ((ui + 1) & 1) * 1024)))
        } else {
            PG8_UNIT(E(acc, cur, wr, wc, fr, fq), PG8_ZERO_ACC())
        }
    }
#undef PG8_UNIT
#undef PG8_ZERO_ACC
    PG8_WAIT_V(0);
    if (!Epi::ALIGN && wr == 0) PG8_BAR;
    PG8_BAR;
#undef PG8_GATHER_OFFS
#undef PG8_GATHER_OFFS_LDS
#undef PG8_SA
#undef PG8_SB
#undef PG8_STAGE
#undef PG8_LDA
#undef PG8_LDB
#undef PG8_MMA
#undef PG8_CAT
#undef PG8_WAIT_V
#undef PG8_WAIT_VX
#undef PG8_TRIP
#undef PG8_WAIT_L
#undef PG8_BAR
#undef PG8_SCHED
}

__device__ __forceinline__ void swap16(unsigned& a, unsigned& b) { const auto r = __builtin_amdgcn_permlane16_swap(a, b, false, false); a = r[0]; b = r[1]; }
struct EpiProj {
    static constexpr bool PERM = true; static constexpr bool AUX = false; static constexpr bool BINIT = false; static constexpr int NVM = 16; static constexpr bool ALIGN = true;
    bf16 *rkv, *att; unsigned char* gate; bf16* lora;
    static __device__ __forceinline__ f32x2 sg255(f32x2 x) {
        const f32x2 t = x * (f32x2){-1.44269504f, -1.44269504f};
        f32x2 e; e.x = __builtin_amdgcn_exp2f(t.x); e.y = __builtin_amdgcn_exp2f(t.y);
        const f32x2 d = e + (f32x2){1.0f, 1.0f};
        f32x2 r; r.x = __builtin_amdgcn_rcpf(d.x); r.y = __builtin_amdgcn_rcpf(d.y);
        const f32x2 q = r * (f32x2){255.0f, 255.0f} + (f32x2){0.5f, 0.5f};
        return (f32x2){fmaxf(q.x, 1.0f), fmaxf(q.y, 1.0f)};
    }
    __device__ __forceinline__ void operator()(const f32x4 (&acc)[2][2][4][2], const Unit& u, int wr, int wc, int fr, int fq) const {
        const int row0 = u.pm * 256 + wr * 64 + fr;
        if (u.pn >= 15 && u.pn < 23) {
            const int col0 = (u.pn - 15) * 256 + wc * 32 + 8 * fq;
#pragma unroll
            for (int ai = 0; ai < 2; ++ai)
#pragma unroll
                for (int m = 0; m < 4; ++m) { unsigned char* rowp = gate + (size_t)(row0 + ai * 128 + m * 16) * C_GATE + col0;
#pragma unroll
                    for (int bj = 0; bj < 2; ++bj) { const f32x4 v0 = acc[ai][bj][m][0], v1 = acc[ai][bj][m][1];
                        const f32x2 a0 = sg255(v0.xy), a1 = sg255(v0.zw), a2 = sg255(v1.xy), a3 = sg255(v1.zw);
                        v2u w; w.x = __builtin_amdgcn_cvt_pk_u8_f32(a1.y, 3, __builtin_amdgcn_cvt_pk_u8_f32(a1.x, 2, __builtin_amdgcn_cvt_pk_u8_f32(a0.y, 1, __builtin_amdgcn_cvt_pk_u8_f32(a0.x, 0, 0u))));
                        w.y = __builtin_amdgcn_cvt_pk_u8_f32(a3.y, 3, __builtin_amdgcn_cvt_pk_u8_f32(a3.x, 2, __builtin_amdgcn_cvt_pk_u8_f32(a2.y, 1, __builtin_amdgcn_cvt_pk_u8_f32(a2.x, 0, 0u))));
                        *(v2u*)(rowp + bj * 128) = w; } }
            return;
        }
        bf16* base; int ldc, colt;
        if (u.pn < 6) { base = rkv; ldc = C_RKV; colt = u.pn * 256; }
        else if (u.pn < 15) { base = att; ldc = C_ATT; colt = (u.pn - 6) * 256; }
        else { base = lora; ldc = C_LORA; colt = (u.pn - 23) * 256; }
        const int col0 = colt + wc * 32 + 8 * fq;
#pragma unroll
        for (int ai = 0; ai < 2; ++ai)
#pragma unroll
            for (int m = 0; m < 4; ++m) { bf16* rowp = base + (size_t)(row0 + ai * 128 + m * 16) * ldc + col0;
#pragma unroll
                for (int bj = 0; bj < 2; ++bj) { const f32x4 v0 = acc[ai][bj][m][0], v1 = acc[ai][bj][m][1];
                    v4u w; w.x = cvt_pk_bf16(v0[0], v0[1]); w.y = cvt_pk_bf16(v0[2], v0[3]); w.z = cvt_pk_bf16(v1[0], v1[1]); w.w = cvt_pk_bf16(v1[2], v1[3]);
                    *(v4u*)(rowp + bj * 128) = w; } }
    }
};
template <bool FIRST> struct EpiMix {
    static constexpr bool PERM = true; static constexpr bool AUX = false; static constexpr bool BINIT = false; static constexpr int NVM = FIRST ? 32 : 48; static constexpr bool ALIGN = true;
    bf16* mixed; const unsigned char* sg; int gcol;
    __device__ __forceinline__ void operator()(const f32x4 (&acc)[2][2][4][2], const Unit& u, int wr, int wc, int fr, int fq) const {
        const int row0 = u.pm * 256 + wr * 64 + fr, col0 = u.pn * 256 + wc * 32 + 8 * fq;
        const float gs = 1.0f / 255.0f;
#pragma unroll
        for (int ai = 0; ai < 2; ++ai) {
            v2u g[4][2]; v4u o[4][2];
#pragma unroll
            for (int m = 0; m < 4; ++m) { const size_t row = (size_t)(row0 + ai * 128 + m * 16);
#pragma unroll
                for (int bj = 0; bj < 2; ++bj) { g[m][bj] = *(const v2u*)(sg + row * C_GATE + gcol + col0 + bj * 128);
                    o[m][bj] = (v4u){0u, 0u, 0u, 0u}; if (!FIRST) o[m][bj] = *(const v4u*)(mixed + row * D + col0 + bj * 128); } }
#pragma unroll
            for (int m = 0; m < 4; ++m) { const size_t row = (size_t)(row0 + ai * 128 + m * 16);
#pragma unroll
                for (int bj = 0; bj < 2; ++bj) { const v2u gg = g[m][bj]; const v4u oo = o[m][bj];
                    const f32x4 v0 = acc[ai][bj][m][0], v1 = acc[ai][bj][m][1];
                    float r[8];
                    r[0] = (float)(gg.x & 255u) * gs * v0[0]; r[1] = (float)((gg.x >> 8) & 255u) * gs * v0[1]; r[2] = (float)((gg.x >> 16) & 255u) * gs * v0[2]; r[3] = (float)(gg.x >> 24) * gs * v0[3];
                    r[4] = (float)(gg.y & 255u) * gs * v1[0]; r[5] = (float)((gg.y >> 8) & 255u) * gs * v1[1]; r[6] = (float)((gg.y >> 16) & 255u) * gs * v1[2]; r[7] = (float)(gg.y >> 24) * gs * v1[3];
                    if (!FIRST) { r[0] += bf_lo(oo.x); r[1] += bf_hi(oo.x); r[2] += bf_lo(oo.y); r[3] += bf_hi(oo.y); r[4] += bf_lo(oo.z); r[5] += bf_hi(oo.z); r[6] += bf_lo(oo.w); r[7] += bf_hi(oo.w); }
                    v4u w; w.x = cvt_pk_bf16(r[0], r[1]); w.y = cvt_pk_bf16(r[2], r[3]); w.z = cvt_pk_bf16(r[4], r[5]); w.w = cvt_pk_bf16(r[6], r[7]);
                    *(v4u*)(mixed + row * D + col0 + bj * 128) = w; } }
            asm volatile("" ::: "memory"); }
    }
};
struct EpiMixF {
    static constexpr bool PERM = true; static constexpr bool AUX = false; static constexpr bool BINIT = false; static constexpr int NVM = 32; static constexpr bool ALIGN = false;
    bf16* mixed; const unsigned char* sg;
    __device__ __forceinline__ void mid(f32x4 (&acc)[2][2][4][2], const Unit& u, int wr, int wc, int fr, int fq) const {
        const int row0 = u.pm * 256 + wr * 64 + fr, col0 = u.pn * 256 + wc * 32 + 8 * fq;
#pragma unroll
        for (int ai = 0; ai < 2; ++ai) { v2u gr[4][2], ga[4][2];
#pragma unroll
            for (int m = 0; m < 4; ++m) { const unsigned char* p = sg + (size_t)(row0 + ai * 128 + m * 16) * C_GATE + col0;
#pragma unroll
                for (int bj = 0; bj < 2; ++bj) { gr[m][bj] = *(const v2u*)(p + bj * 128); ga[m][bj] = *(const v2u*)(p + 1024 + bj * 128); } }
#pragma unroll
            for (int m = 0; m < 4; ++m)
#pragma unroll
                for (int bj = 0; bj < 2; ++bj) { const v2u r = gr[m][bj], a = ga[m][bj];
                    f32x4& v0 = acc[ai][bj][m][0]; f32x4& v1 = acc[ai][bj][m][1];
                    v0[0] *= (float)(r.x & 255u) * __builtin_amdgcn_rcpf((float)(a.x & 255u)); v0[1] *= (float)((r.x >> 8) & 255u) * __builtin_amdgcn_rcpf((float)((a.x >> 8) & 255u));
                    v0[2] *= (float)((r.x >> 16) & 255u) * __builtin_amdgcn_rcpf((float)((a.x >> 16) & 255u)); v0[3] *= (float)(r.x >> 24) * __builtin_amdgcn_rcpf((float)(a.x >> 24));
                    v1[0] *= (float)(r.y & 255u) * __builtin_amdgcn_rcpf((float)(a.y & 255u)); v1[1] *= (float)((r.y >> 8) & 255u) * __builtin_amdgcn_rcpf((float)((a.y >> 8) & 255u));
                    v1[2] *= (float)((r.y >> 16) & 255u) * __builtin_amdgcn_rcpf((float)((a.y >> 16) & 255u)); v1[3] *= (float)(r.y >> 24) * __builtin_amdgcn_rcpf((float)(a.y >> 24)); }
            asm volatile("" ::: "memory"); }
    }
    __device__ __forceinline__ void operator()(const f32x4 (&acc)[2][2][4][2], const Unit& u, int wr, int wc, int fr, int fq) const {
        const int row0 = u.pm * 256 + wr * 64 + fr, col0 = u.pn * 256 + wc * 32 + 8 * fq;
        const float gs = 1.0f / 255.0f;
#pragma unroll
        for (int ai = 0; ai < 2; ++ai) { v2u g[4][2];
#pragma unroll
            for (int m = 0; m < 4; ++m)
#pragma unroll
                for (int bj = 0; bj < 2; ++bj) g[m][bj] = *(const v2u*)(sg + (size_t)(row0 + ai * 128 + m * 16) * C_GATE + 1024 + col0 + bj * 128);
#pragma unroll
            for (int m = 0; m < 4; ++m) { const size_t row = (size_t)(row0 + ai * 128 + m * 16);
#pragma unroll
                for (int bj = 0; bj < 2; ++bj) { const v2u gg = g[m][bj]; const f32x4 v0 = acc[ai][bj][m][0], v1 = acc[ai][bj][m][1];
                    float r[8];
                    r[0] = (float)(gg.x & 255u) * gs * v0[0]; r[1] = (float)((gg.x >> 8) & 255u) * gs * v0[1]; r[2] = (float)((gg.x >> 16) & 255u) * gs * v0[2]; r[3] = (float)(gg.x >> 24) * gs * v0[3];
                    r[4] = (float)(gg.y & 255u) * gs * v1[0]; r[5] = (float)((gg.y >> 8) & 255u) * gs * v1[1]; r[6] = (float)((gg.y >> 16) & 255u) * gs * v1[2]; r[7] = (float)(gg.y >> 24) * gs * v1[3];
                    v4u w; w.x = cvt_pk_bf16(r[0], r[1]); w.y = cvt_pk_bf16(r[2], r[3]); w.z = cvt_pk_bf16(r[4], r[5]); w.w = cvt_pk_bf16(r[6], r[7]);
                    *(v4u*)(mixed + row * D + col0 + bj * 128) = w; } }
            asm volatile("" ::: "memory"); }
    }
};
struct EpiOut {
    static constexpr bool PERM = true; static constexpr bool AUX = false; static constexpr bool BINIT = false; static constexpr int NVM = 52; static constexpr bool ALIGN = false;
    const float* x; bf16* x1; const float* mod;
    __device__ __forceinline__ void operator()(const f32x4 (&acc)[2][2][4][2], const Unit& u, int wr, int wc, int fr, int fq) const {
        const int row0 = u.pm * 256 + wr * 64 + fr, col0 = u.pn * 256 + wc * 32 + 8 * fq;
        const float* g1 = mod + (size_t)(u.pm >> 3) * 6144 + 2048 + col0;
        f32x4 ga[2], gb[2];
#pragma unroll
        for (int bj = 0; bj < 2; ++bj) { ga[bj] = *(const f32x4*)(g1 + bj * 128); gb[bj] = *(const f32x4*)(g1 + bj * 128 + 4); }
#pragma unroll
        for (int ai = 0; ai < 2; ++ai) { f32x4 xa[4][2], xb[4][2];
#pragma unroll
            for (int m = 0; m < 4; ++m)
#pragma unroll
                for (int bj = 0; bj < 2; ++bj) { const size_t off = (size_t)(row0 + ai * 128 + m * 16) * D + col0 + bj * 128; xa[m][bj] = *(const f32x4*)(x + off); xb[m][bj] = *(const f32x4*)(x + off + 4); }
#pragma unroll
            for (int m = 0; m < 4; ++m)
#pragma unroll
                for (int bj = 0; bj < 2; ++bj) { const size_t off = (size_t)(row0 + ai * 128 + m * 16) * D + col0 + bj * 128;
                    const f32x4 ra = xa[m][bj] + ga[bj] * acc[ai][bj][m][0], rb = xb[m][bj] + gb[bj] * acc[ai][bj][m][1];
                    v4u w; w.x = cvt_pk_bf16(ra[0], ra[1]); w.y = cvt_pk_bf16(ra[2], ra[3]); w.z = cvt_pk_bf16(rb[0], rb[1]); w.w = cvt_pk_bf16(rb[2], rb[3]);
                    *(v4u*)(x1 + off) = w; }
            asm volatile("" ::: "memory"); }
    }
};
struct EpiSwiglu {
    static constexpr bool PERM = true; static constexpr int NVM = 4; static constexpr bool AUX = true; static constexpr bool BINIT = true; static constexpr bool ALIGN = false;
    unsigned char* act; const float* b1p;
    __device__ __forceinline__ const float* bias_base() const { return b1p; }
    __device__ __forceinline__ unsigned bias_off(const Unit& u) const { return (unsigned)((u.e * 2048 + u.pn * 256) * 4); }
    __device__ __forceinline__ void init(f32x4 (&acc)[2][2][4][2], int wc, int fq, const LAS float* lb) const {
        const LAS float* bb = lb + wc * 32 + 8 * fq;
        const f32x4 one = (f32x4){1.f, 1.f, 1.f, 1.f};
        const f32x4 bg0 = *(const LAS f32x4*)(bb), bg1 = *(const LAS f32x4*)(bb + 4), bl0 = *(const LAS f32x4*)(bb + 128) + one, bl1 = *(const LAS f32x4*)(bb + 132) + one;
#pragma unroll
        for (int a = 0; a < 2; ++a)
#pragma unroll
            for (int m = 0; m < 4; ++m) { acc[a][0][m][0] = bg0; acc[a][0][m][1] = bg1; acc[a][1][m][0] = bl0; acc[a][1][m][1] = bl1; }
    }
    static __device__ __forceinline__ f32x2 sw2(f32x2 g, f32x2 l) {
        f32x2 gm; gm.x = __builtin_amdgcn_fmed3f(g.x, -3.0e38f, 7.0f); gm.y = __builtin_amdgcn_fmed3f(g.y, -3.0e38f, 7.0f);
        const f32x2 t = gm * (f32x2){-2.45546696f, -2.45546696f};
        f32x2 e; e.x = __builtin_amdgcn_exp2f(t.x); e.y = __builtin_amdgcn_exp2f(t.y);
        const f32x2 d = e + (f32x2){1.0f, 1.0f};
        f32x2 r; r.x = __builtin_amdgcn_rcpf(d.x); r.y = __builtin_amdgcn_rcpf(d.y);
        f32x2 lm; lm.x = __builtin_amdgcn_fmed3f(l.x, -6.0f, 8.0f); lm.y = __builtin_amdgcn_fmed3f(l.y, -6.0f, 8.0f);
        return (gm * r) * lm;
    }
    __device__ __forceinline__ void operator()(const f32x4 (&acc)[2][2][4][2], const Unit& u, int wr, int wc, int fr, int fq, const LAS float* lb) const {
        const int row0 = u.pm * 256 + wr * 64 + fr;
#pragma unroll
        for (int ai = 0; ai < 2; ++ai)
#pragma unroll
            for (int mp = 0; mp < 2; ++mp) { v2u w[2];
#pragma unroll
                for (int q = 0; q < 2; ++q) { const int m = mp * 2 + q;
                    const f32x4 g0 = acc[ai][0][m][0], g1 = acc[ai][0][m][1], l0 = acc[ai][1][m][0], l1 = acc[ai][1][m][1];
                    const f32x2 r0 = sw2(g0.xy, l0.xy), r1 = sw2(g0.zw, l0.zw), r2 = sw2(g1.xy, l1.xy), r3 = sw2(g1.zw, l1.zw);
                    w[q].x = pk4_fp8(r0.x, r0.y, r1.x, r1.y); w[q].y = pk4_fp8(r2.x, r2.y, r3.x, r3.y); }
                unsigned x0 = w[0].x, x1 = w[0].y, y0 = w[1].x, y1 = w[1].y; swap16(x0, y0); swap16(x1, y1);
                *(v4u*)(act + (size_t)(row0 + ai * 128 + (mp * 2 + (fq & 1)) * 16) * D + u.pn * 128 + wc * 32 + 8 * (fq & 2)) = (v4u){x0, x1, y0, y1}; }
    }
};
struct EpiDown {
    static constexpr bool PERM = true; static constexpr int NVM = 8; static constexpr bool AUX = true; static constexpr bool BINIT = true; static constexpr bool ALIGN = true;
    unsigned char* O; const float* b2;
    __device__ __forceinline__ const float* bias_base() const { return b2; }
    __device__ __forceinline__ unsigned bias_off(const Unit& u) const { return (unsigned)((u.e * 1024 + u.pn * 256) * 4); }
    __device__ __forceinline__ void init(f32x4 (&acc)[2][2][4][2], int wc, int fq, const LAS float* lb) const {
        const LAS float* bb = lb + wc * 32 + 8 * fq;
        const f32x4 b00 = *(const LAS f32x4*)(bb), b01 = *(const LAS f32x4*)(bb + 4), b10 = *(const LAS f32x4*)(bb + 128), b11 = *(const LAS f32x4*)(bb + 132);
#pragma unroll
        for (int a = 0; a < 2; ++a)
#pragma unroll
            for (int m = 0; m < 4; ++m) { acc[a][0][m][0] = b00; acc[a][0][m][1] = b01; acc[a][1][m][0] = b10; acc[a][1][m][1] = b11; }
    }
    __device__ __forceinline__ void operator()(const f32x4 (&acc)[2][2][4][2], const Unit& u, int wr, int wc, int fr, int fq, const LAS float*) const {
        const int row0 = u.pm * 256 + wr * 64 + fr, col0 = u.pn * 256 + wc * 32 + 8 * (fq & 2);
#pragma unroll
        for (int ai = 0; ai < 2; ++ai)
#pragma unroll
            for (int mp = 0; mp < 2; ++mp) { unsigned char* rowp = O + (size_t)(row0 + ai * 128 + (mp * 2 + (fq & 1)) * 16) * D + col0;
#pragma unroll
                for (int bj = 0; bj < 2; ++bj) { v2u w[2];
#pragma unroll
                    for (int q = 0; q < 2; ++q) { const f32x4 v0 = acc[ai][bj][mp * 2 + q][0], v1 = acc[ai][bj][mp * 2 + q][1];
                        w[q].x = pk4_fp8(v0[0], v0[1], v0[2], v0[3]); w[q].y = pk4_fp8(v1[0], v1[1], v1[2], v1[3]); }
                    unsigned x0 = w[0].x, x1 = w[0].y, y0 = w[1].x, y1 = w[1].y; swap16(x0, y0); swap16(x1, y1);
                    *(v4u*)(rowp + bj * 128) = (v4u){x0, x1, y0, y1}; } }
    }
};
}

struct Args { const float* in[34]; float* out; unsigned char* ws; int ph_lo, ph_hi; };
struct Frame {
    LAS unsigned char* lds; volatile LAS unsigned* MISC; unsigned* ctl; unsigned char* ws; unsigned char* dout;
    int tid, lane, wave, G, bx;
};
enum InIdx { I_X = 0, I_C, I_ADAW, I_ADAB, I_N1G, I_N2G, I_WIN, I_MURKV, I_MUWAG, I_W0, I_W1, I_W2, I_A0, I_A1, I_A2, I_G1, I_G2, I_KK, I_KA, I_RK, I_LNW, I_LNB, I_QNG, I_KNG, I_RELB,
             I_WBRR, I_WBRA, I_WOUT, I_RTW, I_RTB, I_EW1, I_EB1, I_EW2, I_EB2 };

template <class DM, class RS>
__device__ __forceinline__ void transpose_item(const float* W, int ldw, int K, bf16* WT, int k0, int n0, LAS float* scr, int lane, const DM& dmap, const RS& rs) {
    const int cq = lane & 7, kr = lane >> 3;
#pragma unroll
    for (int i = 0; i < 8; ++i) { const int kk = 8 * i + kr; const f32x4 v = *(const f32x4*)(W + (size_t)(k0 + kk) * ldw + n0 + 4 * cq) * rs(k0 + kk);
        LAS float* d = scr + kk * 33 + 4 * cq; d[0] = v[0]; d[1] = v[1]; d[2] = v[2]; d[3] = v[3]; }
    LDS_WAIT(); asm volatile("" ::: "memory");
    const int c = lane & 7;
#pragma unroll
    for (int j = 0; j < 4; ++j) { const int n = (lane >> 3) + 8 * j; const LAS float* s = scr + (8 * c) * 33 + n;
        v4u o; o.x = cvt_pk_bf16(s[0 * 33], s[1 * 33]); o.y = cvt_pk_bf16(s[2 * 33], s[3 * 33]); o.z = cvt_pk_bf16(s[4 * 33], s[5 * 33]); o.w = cvt_pk_bf16(s[6 * 33], s[7 * 33]);
        *(v4u*)(WT + (size_t)dmap(n0 + n) * K + k0 + 8 * c) = o; }
    LDS_WAIT(); asm volatile("" ::: "memory");
}
template <class DM, class RS>
__device__ __forceinline__ void transpose_item_fp8(const float* W, int ldw, int K, unsigned char* WT8, int k0, int n0, LAS float* scr, int lane, const DM& dmap, const RS& rs) {
    const int cq = lane & 7, kr = lane >> 3;
#pragma unroll
    for (int i = 0; i < 8; ++i) { const int kk = 8 * i + kr; const f32x4 v = *(const f32x4*)(W + (size_t)(k0 + kk) * ldw + n0 + 4 * cq) * (32.0f * rs(k0 + kk));
        LAS float* d = scr + kk * 33 + 4 * cq; d[0] = v[0]; d[1] = v[1]; d[2] = v[2]; d[3] = v[3]; }
    LDS_WAIT(); asm volatile("" ::: "memory");
    const int c = lane & 3;
#pragma unroll
    for (int j = 0; j < 2; ++j) { const int n = (lane >> 2) + 16 * j; const LAS float* s = scr + (16 * c) * 33 + n;
        v4u o; o.x = pk4_fp8(s[0 * 33], s[1 * 33], s[2 * 33], s[3 * 33]); o.y = pk4_fp8(s[4 * 33], s[5 * 33], s[6 * 33], s[7 * 33]);
        o.z = pk4_fp8(s[8 * 33], s[9 * 33], s[10 * 33], s[11 * 33]); o.w = pk4_fp8(s[12 * 33], s[13 * 33], s[14 * 33], s[15 * 33]);
        *(v4u*)(WT8 + (size_t)dmap(n0 + n) * K + k0 + 16 * c) = o; }
    LDS_WAIT(); asm volatile("" ::: "memory");
}
struct CmId { __device__ __forceinline__ int operator()(int n) const { return n; } };
struct CmGlu { __device__ __forceinline__ int operator()(int n) const { const int pn = n >> 8, t = n & 255; return 2 * (pn * 128 + (t & 127)) + (t >> 7); } };
struct DmGlu { __device__ __forceinline__ int operator()(int n) const { const int pn = n >> 8, l = n & 255; return pn * 256 + (l & 1) * 128 + (l >> 1); } };
struct RsOne { __device__ __forceinline__ float operator()(int) const { return 1.0f; } };
struct RsMu { const float* mu; float a, b; __device__ __forceinline__ float operator()(int k) const { return a + b * mu[k]; } };

__device__ __forceinline__ void p0_prologue(Frame& F, const Args& A) {
    unsigned char* ws = F.ws;
    const int gw = F.bx * 8 + F.wave, NGW = F.G * 8;
    __syncthreads();
    {
        LAS float* sc = (LAS float*)F.lds;
        const float* c = A.in[I_C];
        for (int i0 = ((int)threadIdx.x); i0 < 32 * 1024; i0 += 512 * 8) { float cv_[8];
#pragma unroll
            for (int q = 0; q < 8; ++q) cv_[q] = c[i0 + 512 * q];
            asm volatile("" ::: "memory");
#pragma unroll
            for (int q = 0; q < 8; ++q) { const int i = i0 + 512 * q, b = i >> 10, k = i & 1023; const float v = cv_[q]; sc[k * 32 + b] = v * sigmoidf_(v); } }
        __syncthreads();
        const int ks = ((int)threadIdx.x) >> 5, jc = ((int)threadIdx.x) & 31;
        float accv[32];
#pragma unroll
        for (int b = 0; b < 32; ++b) accv[b] = 0.f;
        for (int col0 = F.bx * 24; col0 < 6144; col0 += F.G * 24) {
            if (jc < 24) {
                const float* w = A.in[I_ADAW] + col0 + jc;
                for (int kk0 = 0; kk0 < 64; kk0 += 16) { float wv[16];
#pragma unroll
                    for (int q = 0; q < 16; ++q) wv[q] = w[(size_t)(ks * 64 + kk0 + q) * 6144];
#pragma unroll
                    for (int q = 0; q < 16; ++q) { const int k = ks * 64 + kk0 + q;
#pragma unroll
                        for (int b4 = 0; b4 < 8; ++b4) { const f32x4 s4 = *(const LAS f32x4*)(sc + k * 32 + b4 * 4);
                            accv[b4 * 4 + 0] += s4[0] * wv[q]; accv[b4 * 4 + 1] += s4[1] * wv[q]; accv[b4 * 4 + 2] += s4[2] * wv[q]; accv[b4 * 4 + 3] += s4[3] * wv[q]; } } }
            }
            LAS float* rb = (LAS float*)(F.lds + 131072);
            for (int bq = 0; bq < 4; ++bq) {
                if (jc < 24) {
#pragma unroll
                    for (int b = 0; b < 8; ++b) rb[(ks * 24 + jc) * 8 + b] = accv[bq * 8 + b]; }
                __syncthreads();
                if (((int)threadIdx.x) < 24 * 8) { const int j = ((int)threadIdx.x) >> 3, b = ((int)threadIdx.x) & 7; float s = 0.f;
#pragma unroll
                    for (int q = 0; q < 16; ++q) s += rb[(q * 24 + j) * 8 + b];
                    ((float*)(ws + WS_MOD))[(size_t)(bq * 8 + b) * 6144 + col0 + j] = s + A.in[I_ADAB][col0 + j]; }
                __syncthreads();
            }
#pragma unroll
            for (int b = 0; b < 32; ++b) accv[b] = 0.f;
        }
        __syncthreads();
    }
    {
        LAS float* scr = (LAS float*)(F.lds + F.wave * 16384);
        unsigned char* wext = (unsigned char*)(ws + WS_WEXT);
        const float* mu = A.in[I_MUWAG];
        constexpr int IT_WIN = 16 * 184, IT_LORA = 16 * 16, IT_W1 = 32 * 16 * 64, IT_W2 = 32 * 16 * 32, IT_BRR = 8 * 32, IT_BRA = 4 * 32, IT_OUT = 16 * 32, IT_L2 = 16 + 16 + 32;
        constexpr int NIT = IT_WIN + IT_LORA + IT_W1 + IT_W2 + IT_BRR + IT_BRA + IT_OUT + IT_L2;
        for (int it = gw; it < NIT; it += NGW) {
            int r = it;
            if (r < IT_WIN) { const int kb = r / 184, nb = r % 184; transpose_item_fp8(A.in[I_WIN], 5888, 1024, wext, 64 * kb, 32 * nb, scr, ((int)threadIdx.x & 63), CmId{}, RsOne{}); continue; } r -= IT_WIN;
            if (r < IT_LORA) {
                const int kb = r / 16, nb = r % 16, prev = nb >> 3, q = nb & 7;
                const float* src; int ldw, n0, mi;
                if (q < 2) { src = A.in[I_W1]; ldw = 64; n0 = 32 * q; mi = 0; } else if (q < 4) { src = A.in[I_A1]; ldw = 64; n0 = 32 * (q - 2); mi = 1; } else { src = A.in[I_G1]; ldw = 128; n0 = 32 * (q - 4); mi = 2; }
                const RsMu rs{mu + mi * 1024, prev ? 0.f : 1.f, prev ? 1.f : -1.f};
                transpose_item_fp8(src, ldw, 1024, wext + (size_t)(5888 + 32 * nb - n0) * 1024, 64 * kb, n0, scr, ((int)threadIdx.x & 63), CmId{}, rs); continue; } r -= IT_LORA;
            if (r < IT_W1) { const int e = r / 1024, q = r % 1024, kb = q / 64, nb = q % 64;
                transpose_item_fp8(A.in[I_EW1] + (size_t)e * 1024 * 2048, 2048, 1024, (unsigned char*)(ws + WS_W1T) + (size_t)e * 2048 * 1024, 64 * kb, 32 * nb, scr, ((int)threadIdx.x & 63), DmGlu{}, RsOne{}); continue; } r -= IT_W1;
            if (r < IT_W2) { const int e = r / 512, q = r % 512, kb = q / 32, nb = q % 32;
                transpose_item_fp8(A.in[I_EW2] + (size_t)e * 1024 * 1024, 1024, 1024, (unsigned char*)(ws + WS_W2E) + (size_t)e * 1024 * 1024, 64 * kb, 32 * nb, scr, ((int)threadIdx.x & 63), CmId{}, RsOne{}); continue; } r -= IT_W2;
            if (r < IT_BRR) { const int kb = r / 32, nb = r % 32; transpose_item(A.in[I_WBRR], 1024, 768, (bf16*)(ws + WS_WBRR), 64 * kb, 32 * nb, scr, ((int)threadIdx.x & 63), CmId{}, RsOne{}); continue; } r -= IT_BRR;
            if (r < IT_BRA) { const int kb = r / 32, nb = r % 32; transpose_item(A.in[I_WBRA], 1024, 768, (bf16*)(ws + WS_WBRR) + 512, 64 * kb, 32 * nb, scr, ((int)threadIdx.x & 63), CmId{}, RsOne{}); continue; } r -= IT_BRA;
            if (r < IT_OUT) { const int kb = r / 32, nb = r % 32; transpose_item(A.in[I_WOUT], 1024, 1024, (bf16*)(ws + WS_WOUT), 64 * kb, 32 * nb, scr, ((int)threadIdx.x & 63), CmId{}, RsOne{}); continue; } r -= IT_OUT;
            if (r < 16) { transpose_item(A.in[I_W2], 512, 64, (bf16*)(ws + WS_W2T), 0, 32 * r, scr, ((int)threadIdx.x & 63), CmId{}, RsOne{}); continue; } r -= 16;
            if (r < 16) { transpose_item(A.in[I_A2], 512, 64, (bf16*)(ws + WS_A2T), 0, 32 * r, scr, ((int)threadIdx.x & 63), CmId{}, RsOne{}); continue; } r -= 16;
            { const int kb = r / 16, nb = r % 16; transpose_item(A.in[I_G2], 512, 128, (bf16*)(ws + WS_G2T), 64 * kb, 32 * nb, scr, ((int)threadIdx.x & 63), CmId{}, RsOne{}); }
        }
    }
    {
        const CmGlu cm; float* b1p = (float*)(ws + WS_B1P);
        for (int i = F.bx * 512 + ((int)threadIdx.x); i < 32 * 2048; i += F.G * 512) { const int e = i >> 11, n = i & 2047; b1p[i] = A.in[I_EB1][e * 2048 + cm(n)]; }
        if (F.bx == 0) { float* lut = (float*)(ws + WS_LUT);
            for (int i = ((int)threadIdx.x); i < 12 * 132; i += 512) { const int hd = i / 132, st = i % 132; float v = 0.f;
                if (st <= 128) { const int gi = hd >> 2, dil = gi == 0 ? 1 : (gi == 1 ? 4 : 16), dist = st * dil; int bucket;
                    if (dist < 16) bucket = dist; else { const int lg = 16 + (int)(logf((float)dist / 16.0f) / logf(128.0f) * 16.0f); bucket = lg < 31 ? lg : 31; }
                    v = A.in[I_RELB][bucket * 12 + hd]; }
                lut[i] = v; } }
    }
}

__device__ __forceinline__ void p1_norm(Frame& F, const Args& A) {
    const float* mod = (const float*)(F.ws + WS_MOD);
    unsigned char* H = (unsigned char*)(F.dout + DO_H);
    for (int blk = F.bx; blk < NTOK / 256; blk += F.G) {
        const int b = blk >> 3; const float* md = mod + (size_t)b * 6144;
        f32x4 gs[4], sh[4];
#pragma unroll
        for (int j = 0; j < 4; ++j) { const int k = 4 * ((int)threadIdx.x & 63) + 256 * j; const f32x4 g = *(const f32x4*)(A.in[I_N1G] + k), sc = *(const f32x4*)(md + 1024 + k); gs[j] = g * (sc + 1.0f); sh[j] = *(const f32x4*)(md + k); }
        const int ln = ((int)threadIdx.x & 63);
        for (int rr = 0; rr < 32; rr += 4) {
            const size_t row = (size_t)blk * 256 + F.wave * 32 + rr;
            const f32x4* xr = (const f32x4*)(A.in[I_X] + row * D) + ln;
            f32x4 v[4][4];
#pragma unroll
            for (int q = 0; q < 4; ++q)
#pragma unroll
                for (int j = 0; j < 4; ++j) v[q][j] = xr[256 * q + 64 * j];
            v4u ow[4];
#pragma unroll
            for (int q = 0; q < 4; ++q) {
                float s = 0.f;
#pragma unroll
                for (int j = 0; j < 4; ++j) s += (v[q][j][0] * v[q][j][0] + v[q][j][1] * v[q][j][1]) + (v[q][j][2] * v[q][j][2] + v[q][j][3] * v[q][j][3]);
                const float rstd = rsqrtf(wave_sum(s) * (1.0f / D) + 1e-6f);
                unsigned w4[4];
#pragma unroll
                for (int j = 0; j < 4; ++j) { const f32x4 y = v[q][j] * rstd * gs[j] + sh[j]; w4[j] = pk4_fp8(y[0], y[1], y[2], y[3]); }
                ow[q] = quad_transpose(w4[0], w4[1], w4[2], w4[3], ln);
            }
#pragma unroll
            for (int q = 0; q < 4; ++q) *(v4u*)(H + (row + q) * D + 256 * (ln & 3) + 16 * (ln >> 2)) = ow[q];
        }
    }
}

constexpr int RK_T = 64;
constexpr int R_AW = 0, R_AA = 9216, R_AG = 18432;
constexpr int R_BHT = 0, R_KHT = 10240, R_VT = 20480;
constexpr int R_WL = 35840, R_AL = R_WL + 16384;
constexpr int R_AT = 35840, R_RT = R_AT + 9216, R_BT = R_RT + 9216, R_KT = R_BT + 9216;
constexpr int R_AKV = R_BT;
constexpr int R_GG = 72704;
constexpr int R_LD = R_GG + 16384;
constexpr int R_YB = R_LD;
constexpr int R_AAB = R_LD + 16384;
constexpr int R_AAK = R_AAB + 8192, R_ARB = R_AAK + 5120, R_ARK = R_ARB + 5120;
constexpr int R_TT = R_ARK + 5120;
constexpr int R_LAM = R_TT + 5120;
constexpr int R_CST = R_LAM + 512;
constexpr int R_EX = R_CST + 2560;
constexpr int R_END = R_EX + 16384;
constexpr int R_AL2 = R_AAB;
static_assert(R_END <= MISC_OFF && R_KT + 9216 <= R_GG, "rwkv LDS map");

__device__ __forceinline__ bf16x8 ldsA_nat(const LAS unsigned char* p) { return *(const LAS bf16x8*)p; }
__device__ __forceinline__ bf16x8 ldsA_perm(const LAS unsigned char* p) {
    const v2u lo = *(const LAS v2u*)p, hi = *(const LAS v2u*)(p + 16); const v4u w = (v4u){lo.x, lo.y, hi.x, hi.y}; return __builtin_bit_cast(bf16x8, w); }
__device__ __forceinline__ bf16x8 acc_frag(const f32x16& x, int s) {
    v4u w; w.x = cvt_pk_bf16(x[8 * s + 0], x[8 * s + 1]); w.y = cvt_pk_bf16(x[8 * s + 2], x[8 * s + 3]); w.z = cvt_pk_bf16(x[8 * s + 4], x[8 * s + 5]); w.w = cvt_pk_bf16(x[8 * s + 6], x[8 * s + 7]);
    return __builtin_bit_cast(bf16x8, w); }

__device__ __forceinline__ void p3_rwkv(Frame& F, const Args& A) {
    LAS unsigned char* L = F.lds;
    const bf16* prkv = (const bf16*)(F.ws + WS_PRKV);
    const bf16* plora = (const bf16*)(F.dout + DO_PLORA);
    bf16* yr = (bf16*)(F.dout + DO_YR);
    const int tid = ((int)threadIdx.x), lane = ((int)threadIdx.x & 63), wave = F.wave, r32 = lane & 31, hh = lane >> 5;
    for (int unit = F.bx; unit < BATCH * 8; unit += F.G) {
        const int b = unit >> 3, h = unit & 7;
        const bf16* w2t = (const bf16*)(F.ws + WS_W2T) + (size_t)h * 64 * 64; const bf16* a2t = (const bf16*)(F.ws + WS_A2T) + (size_t)h * 64 * 64; const bf16* g2t = (const bf16*)(F.ws + WS_G2T) + (size_t)h * 64 * 128;
        const int tt = tid >> 3, cg = tid & 7, ch = h * 64 + 8 * cg;
        f32x16 Hacc[2]; Hacc[0] = (f32x16){}; Hacc[1] = (f32x16){};
        v4u pl[8], pr[6];
#define RK_BAR() asm volatile("s_waitcnt lgkmcnt(0)\n\ts_barrier" ::: "memory")
#define RK_PREFETCH(t0) do { const size_t tokc = (size_t)b * SEQ + (t0) + tt; const bool hp = ((t0) + tt) > 0; \
            const bf16* lc = plora + tokc * C_LORA + 8 * cg; const bf16* lp = plora + (tokc - 1) * C_LORA + 256 + 8 * cg; \
            _Pragma("unroll") for (int q = 0; q < 4; ++q) { pl[q] = *(const v4u*)(lc + 64 * q); pl[4 + q] = hp ? *(const v4u*)(lp + 64 * q) : (v4u){0u, 0u, 0u, 0u}; } \
            const bf16* rc = prkv + tokc * C_RKV + ch; const bf16* rp = prkv + (tokc - 1) * C_RKV + ch; \
            _Pragma("unroll") for (int q = 0; q < 3; ++q) { pr[q] = *(const v4u*)(rc + 512 * q); pr[3 + q] = hp ? *(const v4u*)(rp + 512 * q) : (v4u){0u, 0u, 0u, 0u}; } } while (0)
        v4u ypend = (v4u){0u, 0u, 0u, 0u};
        RK_PREFETCH(0);
        for (int i = tid; i < 640; i += 512) { const int ar = i >> 6, c = i & 63;
            const float* src = ar < 3 ? A.in[I_MURKV] + 512 * ar : ar == 3 ? A.in[I_W0] : ar == 4 ? A.in[I_A0] : ar == 5 ? A.in[I_KK] : ar == 6 ? A.in[I_KA] : ar == 7 ? A.in[I_RK] : ar == 8 ? A.in[I_LNW] : A.in[I_LNB];
            ((LAS float*)(L + R_CST))[i] = src[h * 64 + c]; }
        __syncthreads();
        for (int t0 = 0; t0 < SEQ; t0 += RK_T) {
            int zz; asm volatile("v_mov_b32 %0, 0" : "=v"(zz));
            const int chz = ch + zz, hhz = hh + zz, r32z = r32 + zz, lanez = lane + zz, ttz = tt + zz, cgz = cg + zz;
            v4u bwf[4], bgf[8];
            { const int ct_ = wave & 1; const bf16* Bsrc_ = (wave < 4) ? w2t : a2t;
#pragma unroll
              for (int s_ = 0; s_ < 4; ++s_) bwf[s_] = *(const v4u*)(Bsrc_ + (size_t)(ct_ * 32 + r32z) * 64 + 16 * s_ + 8 * hhz);
#pragma unroll
              for (int s_ = 0; s_ < 8; ++s_) bgf[s_] = (wave < 4) ? *(const v4u*)(g2t + (size_t)(ct_ * 32 + r32z) * 128 + 16 * s_ + 8 * hhz) : (v4u){0u, 0u, 0u, 0u}; }
            {
#pragma unroll
                for (int q = 0; q < 4; ++q) { const v4u c = pl[q], p = pl[4 + q]; float s[8];
                    s[0] = bf_lo(c.x) + bf_lo(p.x); s[1] = bf_hi(c.x) + bf_hi(p.x); s[2] = bf_lo(c.y) + bf_lo(p.y); s[3] = bf_hi(c.y) + bf_hi(p.y);
                    s[4] = bf_lo(c.z) + bf_lo(p.z); s[5] = bf_hi(c.z) + bf_hi(p.z); s[6] = bf_lo(c.w) + bf_lo(p.w); s[7] = bf_hi(c.w) + bf_hi(p.w);
                    if (q == 0) {
#pragma unroll
                        for (int j = 0; j < 8; ++j) s[j] = 1.0f - 2.0f * __builtin_amdgcn_rcpf(1.0f + __expf(2.0f * s[j])); }
                    else if (q >= 2) {
#pragma unroll
                        for (int j = 0; j < 8; ++j) s[j] = sigmoidf_(s[j]); }
                    v4u o; o.x = cvt_pk_bf16(s[0], s[1]); o.y = cvt_pk_bf16(s[2], s[3]); o.z = cvt_pk_bf16(s[4], s[5]); o.w = cvt_pk_bf16(s[6], s[7]);
                    LAS unsigned char* dst = (q == 0) ? (L + R_AW + ttz * 144 + cgz * 16) : (q == 1) ? (L + R_AA + ttz * 144 + cgz * 16) : (L + R_AG + ttz * 272 + (q - 2) * 128 + cgz * 16);
                    *(LAS v4u*)dst = o; }
            }
            float r8[8], k8[8], v8[8], a8[8], b8[8]; float bonus;
            {
                const LAS float* cs = (const LAS float*)(L + R_CST) + 8 * cgz;
                const f32x4 m0 = *(const LAS f32x4*)(cs), m1 = *(const LAS f32x4*)(cs + 4), m2 = *(const LAS f32x4*)(cs + 64), m3 = *(const LAS f32x4*)(cs + 68), m4 = *(const LAS f32x4*)(cs + 128), m5 = *(const LAS f32x4*)(cs + 132);
                const float mur[8] = {m0[0], m0[1], m0[2], m0[3], m1[0], m1[1], m1[2], m1[3]}, muk[8] = {m2[0], m2[1], m2[2], m2[3], m3[0], m3[1], m3[2], m3[3]}, muv[8] = {m4[0], m4[1], m4[2], m4[3], m5[0], m5[1], m5[2], m5[3]};
#define UNPK8(dst, u) do { dst[0] = bf_lo(u.x); dst[1] = bf_hi(u.x); dst[2] = bf_lo(u.y); dst[3] = bf_hi(u.y); dst[4] = bf_lo(u.z); dst[5] = bf_hi(u.z); dst[6] = bf_lo(u.w); dst[7] = bf_hi(u.w); } while (0)
                float c8[8], p8[8];
                UNPK8(c8, pr[0]); UNPK8(p8, pr[3]);
#pragma unroll
                for (int j = 0; j < 8; ++j) r8[j] = c8[j] + (p8[j] - c8[j]) * mur[j];
                UNPK8(c8, pr[1]); UNPK8(p8, pr[4]);
#pragma unroll
                for (int j = 0; j < 8; ++j) k8[j] = c8[j] + (p8[j] - c8[j]) * muk[j];
                UNPK8(c8, pr[2]); UNPK8(p8, pr[5]);
#pragma unroll
                for (int j = 0; j < 8; ++j) v8[j] = c8[j] + (p8[j] - c8[j]) * muv[j];
            }
            RK_BAR();
            {
                const int rt = (wave >> 1) & 1, ct = wave & 1;
                const LAS unsigned char* Ab = L + ((wave < 4) ? R_AW : R_AA) + (rt * 32 + r32z) * 144 + hhz * 16;
                f32x16 acc = {};
#pragma unroll
                for (int s = 0; s < 4; ++s) acc = __builtin_amdgcn_mfma_f32_32x32x16_bf16(*(const LAS bf16x8*)(Ab + s * 32), __builtin_bit_cast(bf16x8, bwf[s]), acc, 0, 0, 0);
                if (wave >= 4) { LAS float* o = (LAS float*)(L + R_AL2);
#pragma unroll
                    for (int r = 0; r < 16; ++r) o[(rt * 32 + crow(r, hhz)) * 64 + ct * 32 + r32z] = acc[r]; }
                else {
                    const float w0c = ((const LAS float*)(L + R_CST))[192 + ct * 32 + r32z];
                    float x[16], S[4], O[4];
#pragma unroll
                    for (int r = 0; r < 16; ++r) x[r] = -0.87505297f * __builtin_amdgcn_rcpf(1.0f + __builtin_amdgcn_exp2f(-1.44269504f * (w0c + acc[r])));
#pragma unroll
                    for (int g = 0; g < 4; ++g) { S[g] = (x[4 * g] + x[4 * g + 1]) + (x[4 * g + 2] + x[4 * g + 3]); O[g] = __shfl_xor(S[g], 32); }
                    LAS float* oc = (LAS float*)(L + R_LD) + (rt * 32 + 4 * hhz) * 64 + ct * 32 + r32z; LAS float* oe = (LAS float*)(L + R_EX) + (rt * 32 + 4 * hhz) * 64 + ct * 32 + r32z;
                    float E = 0.f;
#pragma unroll
                    for (int g = 0; g < 4; ++g) { float run = E + (hhz ? O[g] : 0.f);
#pragma unroll
                        for (int q = 0; q < 4; ++q) { oe[(8 * g + q) * 64] = run; run += x[4 * g + q]; oc[(8 * g + q) * 64] = run; }
                        E += S[g] + O[g]; }
                    if (hhz == 0) ((LAS float*)(L + R_LAM))[rt * 64 + ct * 32 + r32z] = __builtin_amdgcn_exp2f(E);
                }
                if (wave < 4) {
                    const LAS unsigned char* Ag = L + R_AG + (rt * 32 + r32z) * 272 + hhz * 16;
                    f32x16 accg = {};
#pragma unroll
                    for (int s = 0; s < 8; ++s) accg = __builtin_amdgcn_mfma_f32_32x32x16_bf16(*(const LAS bf16x8*)(Ag + s * 32), __builtin_bit_cast(bf16x8, bgf[s]), accg, 0, 0, 0);
                    LAS float* og = (LAS float*)(L + R_GG);
#pragma unroll
                    for (int r = 0; r < 16; ++r) og[(rt * 32 + crow(r, hhz)) * 64 + ct * 32 + r32z] = accg[r];
                }
            }
            RK_BAR();
            if (t0 > 0) *(v4u*)(yr + ((size_t)b * SEQ + (t0 - RK_T) + ttz) * C_YC + ch) = ypend;
            if (t0 + RK_T < SEQ) RK_PREFETCH(t0 + RK_T);
            {
                const LAS float* al = (const LAS float*)(L + R_AL2) + ttz * 64 + 8 * cgz;
                const f32x4 al0 = *(const LAS f32x4*)al, al1 = *(const LAS f32x4*)(al + 4);
                const float alv[8] = {al0[0], al0[1], al0[2], al0[3], al1[0], al1[1], al1[2], al1[3]};
                const LAS float* cs = (const LAS float*)(L + R_CST) + 256 + 8 * cgz;
                const f32x4 c2 = *(const LAS f32x4*)(cs), c3 = *(const LAS f32x4*)(cs + 4),
                            c4 = *(const LAS f32x4*)(cs + 64), c5 = *(const LAS f32x4*)(cs + 68), c6 = *(const LAS f32x4*)(cs + 128), c7 = *(const LAS f32x4*)(cs + 132),
                            c8_ = *(const LAS f32x4*)(cs + 192), c9 = *(const LAS f32x4*)(cs + 196);
                const float a0v[8] = {c2[0], c2[1], c2[2], c2[3], c3[0], c3[1], c3[2], c3[3]}, kkc[8] = {c4[0], c4[1], c4[2], c4[3], c5[0], c5[1], c5[2], c5[3]},
                            kac[8] = {c6[0], c6[1], c6[2], c6[3], c7[0], c7[1], c7[2], c7[3]}, rkc[8] = {c8_[0], c8_[1], c8_[2], c8_[3], c9[0], c9[1], c9[2], c9[3]};
                float ssq = 0.f, asg[8];
#pragma unroll
                for (int j = 0; j < 8; ++j) {
                    asg[j] = sigmoidf_(a0v[j] + alv[j]);
                    a8[j] = k8[j] * kkc[j]; ssq += a8[j] * a8[j]; }
                ssq = reduce8(ssq);
                const float inv = 1.0f / fmaxf(sqrtf(ssq), 1e-12f);
                float bon = 0.f;
#pragma unroll
                for (int j = 0; j < 8; ++j) { const float kkn = a8[j] * inv; k8[j] = k8[j] * (1.0f + (asg[j] - 1.0f) * kac[j]); b8[j] = kkn * asg[j]; a8[j] = -kkn; bon += r8[j] * k8[j] * rkc[j]; }
                bonus = reduce8(bon);
                const int cc = ttz >> 5, tl = ttz & 31;
                const LAS float* cp = (const LAS float*)(L + R_LD) + ttz * 64 + 8 * cgz; const LAS float* xp = (const LAS float*)(L + R_EX) + ttz * 64 + 8 * cgz; const LAS float* cl = (const LAS float*)(L + R_LAM) + cc * 64 + 8 * cgz;
                const f32x4 q0 = *(const LAS f32x4*)cp, q1 = *(const LAS f32x4*)(cp + 4), x0 = *(const LAS f32x4*)xp, x1 = *(const LAS f32x4*)(xp + 4), e0 = *(const LAS f32x4*)cl, e1 = *(const LAS f32x4*)(cl + 4);
                const float cum[8] = {q0[0], q0[1], q0[2], q0[3], q1[0], q1[1], q1[2], q1[3]}, exc[8] = {x0[0], x0[1], x0[2], x0[3], x1[0], x1[1], x1[2], x1[3]}, lamv[8] = {e0[0], e0[1], e0[2], e0[3], e1[0], e1[1], e1[2], e1[3]};
                float at[8], rt_[8], bt[8], kt[8];
                LAS bf16* bht = (LAS bf16*)(L + R_BHT + cc * 5120); LAS bf16* kht = (LAS bf16*)(L + R_KHT + cc * 5120); LAS bf16* vt = (LAS bf16*)(L + R_VT + cc * 5120);
#pragma unroll
                for (int j = 0; j < 8; ++j) { const float em = __builtin_amdgcn_exp2f(-cum[j]), ep = __builtin_amdgcn_exp2f(cum[j]), ex = __builtin_amdgcn_exp2f(exc[j]), eh = lamv[j] * em;
                    at[j] = a8[j] * ex; rt_[j] = r8[j] * ep; bt[j] = b8[j] * em; kt[j] = k8[j] * em;
                    const int c = 8 * cgz + j;
                    bht[c * 40 + tl] = (bf16)(cvt_pk_bf16(b8[j] * eh, 0.f) & 0xffffu); kht[c * 40 + tl] = (bf16)(cvt_pk_bf16(k8[j] * eh, 0.f) & 0xffffu); vt[c * 40 + tl] = (bf16)(cvt_pk_bf16(v8[j], 0.f) & 0xffffu); }
#define PK8(x) (v4u){cvt_pk_bf16(x[0], x[1]), cvt_pk_bf16(x[2], x[3]), cvt_pk_bf16(x[4], x[5]), cvt_pk_bf16(x[6], x[7])}
                const int ro = cc * 4608 + tl * 144 + cgz * 16;
                *(LAS v4u*)(L + R_AT + ro) = PK8(at); *(LAS v4u*)(L + R_RT + ro) = PK8(rt_); *(LAS v4u*)(L + R_BT + ro) = PK8(bt); *(LAS v4u*)(L + R_KT + ro) = PK8(kt);
            }
            RK_BAR();
            {
                const int cc = wave >> 2, pi = wave & 3;
                const LAS unsigned char* Ab = L + ((pi < 2) ? R_AT : R_RT) + cc * 4608 + r32z * 144 + hhz * 16;
                const LAS unsigned char* Bb = L + ((pi & 1) ? R_KT : R_BT) + cc * 4608 + r32z * 144 + hhz * 16;
                f32x16 acc = {};
#pragma unroll
                for (int s = 0; s < 4; ++s) acc = __builtin_amdgcn_mfma_f32_32x32x16_bf16(*(const LAS bf16x8*)(Ab + s * 32), *(const LAS bf16x8*)(Bb + s * 32), acc, 0, 0, 0);
                if (pi == 0) { LAS float* o = (LAS float*)(L + R_AAB) + cc * 1024;
#pragma unroll
                    for (int r = 0; r < 16; ++r) { const int t = crow(r, hhz); o[t * 32 + r32z] = (r32z < t) ? acc[r] : 0.f; } }
                else { LAS bf16* o = (LAS bf16*)(L + (pi == 1 ? R_AAK : (pi == 2 ? R_ARB : R_ARK)) + cc * 2560);
#pragma unroll
                    for (int r = 0; r < 16; ++r) { const int t = crow(r, hhz); const bool keep = (pi == 1) ? (r32z < t) : (r32z <= t); o[t * 40 + r32z] = (bf16)(cvt_pk_bf16(keep ? acc[r] : 0.f, 0.f) & 0xffffu); } }
            }
            RK_BAR();
            if (wave == 2) {
                const int cc = hhz, j = r32z; const LAS float* Ar = (const LAS float*)(L + R_AAB) + cc * 1024;
                float Tr[32];
                f32x4 rw[2][8];
#define RK_ROW(t_) do { _Pragma("unroll") for (int s4_ = 0; s4_ < ((t_) + 3) / 4; ++s4_) rw[(t_) & 1][s4_] = *(const LAS f32x4*)(Ar + (t_) * 32 + 4 * s4_); } while (0)
                RK_ROW(1);
#pragma unroll
                for (int t = 0; t < 32; ++t) { float ac[4] = {(t == j) ? 1.0f : 0.0f, 0.f, 0.f, 0.f};
                    if (t + 1 < 32 && t >= 1) RK_ROW(t + 1);
#pragma unroll
                    for (int s4 = 0; s4 < (t + 3) / 4; ++s4) { const f32x4 a4 = rw[t & 1][s4];
#pragma unroll
                        for (int q = 0; q < 4; ++q) if (4 * s4 + q < t) ac[q] += a4[q] * Tr[4 * s4 + q]; }
                    Tr[t] = (ac[0] + ac[1]) + (ac[2] + ac[3]); asm volatile("" ::: "memory"); }
#undef RK_ROW
                LAS bf16* o = (LAS bf16*)(L + R_TT + cc * 2560);
#pragma unroll
                for (int t = 0; t < 32; ++t) o[t * 40 + j] = (bf16)(cvt_pk_bf16(Tr[t], 0.f) & 0xffffu);
            } else if (wave >= 4) {
                const int cc = (wave >> 1) & 1, vt2 = wave & 1;
                const LAS unsigned char* Ab = L + R_AAK + cc * 2560 + r32z * 80 + hhz * 16; const LAS unsigned char* Bb = L + R_VT + cc * 5120 + (vt2 * 32 + r32z) * 80 + hhz * 16;
                f32x16 acc = {};
#pragma unroll
                for (int s = 0; s < 2; ++s) acc = __builtin_amdgcn_mfma_f32_32x32x16_bf16(ldsA_nat(Ab + s * 32), ldsA_nat(Bb + s * 32), acc, 0, 0, 0);
                LAS f32x4* o = (LAS f32x4*)(L + R_AKV) + (cc * 2 + vt2) * 256 + lanez;
#pragma unroll
                for (int q = 0; q < 4; ++q) o[q * 64] = (f32x4){acc[4 * q], acc[4 * q + 1], acc[4 * q + 2], acc[4 * q + 3]};
            }
            RK_BAR();
            if (wave < 2) {
#pragma unroll
                for (int cc = 0; cc < 2; ++cc) {
                    bf16x8 Hb[2][2];
#pragma unroll
                    for (int kt2 = 0; kt2 < 2; ++kt2)
#pragma unroll
                        for (int s = 0; s < 2; ++s) Hb[kt2][s] = acc_frag(Hacc[kt2], s);
                    f32x16 rhs, y = {};
                    { const LAS f32x4* ip = (const LAS f32x4*)(L + R_AKV) + (cc * 2 + wave) * 256 + lanez;
#pragma unroll
                      for (int q = 0; q < 4; ++q) { const f32x4 x = ip[q * 64]; rhs[4 * q] = x[0]; rhs[4 * q + 1] = x[1]; rhs[4 * q + 2] = x[2]; rhs[4 * q + 3] = x[3]; } }
                    const LAS unsigned char* Atb = L + R_AT + cc * 4608 + r32z * 144 + hhz * 8; const LAS unsigned char* Rtb = L + R_RT + cc * 4608 + r32z * 144 + hhz * 8;
#pragma unroll
                    for (int kt2 = 0; kt2 < 2; ++kt2)
#pragma unroll
                        for (int s = 0; s < 2; ++s) { rhs = __builtin_amdgcn_mfma_f32_32x32x16_bf16(ldsA_perm(Atb + (32 * kt2 + 16 * s) * 2), Hb[kt2][s], rhs, 0, 0, 0);
                            y = __builtin_amdgcn_mfma_f32_32x32x16_bf16(ldsA_perm(Rtb + (32 * kt2 + 16 * s) * 2), Hb[kt2][s], y, 0, 0, 0); }
                    f32x16 u = {};
                    const LAS unsigned char* Tb = L + R_TT + cc * 2560 + r32z * 80 + hhz * 8;
#pragma unroll
                    for (int s = 0; s < 2; ++s) u = __builtin_amdgcn_mfma_f32_32x32x16_bf16(ldsA_perm(Tb + 32 * s), acc_frag(rhs, s), u, 0, 0, 0);
                    bf16x8 ub[2], vb[2];
#pragma unroll
                    for (int s = 0; s < 2; ++s) { ub[s] = acc_frag(u, s); vb[s] = ldsA_nat(L + R_VT + cc * 5120 + (wave * 32 + r32z) * 80 + hhz * 16 + 32 * s); }
                    const LAS unsigned char* Rbp = L + R_ARB + cc * 2560 + r32z * 80 + hhz * 8; const LAS unsigned char* Rkn = L + R_ARK + cc * 2560 + r32z * 80 + hhz * 16;
#pragma unroll
                    for (int s = 0; s < 2; ++s) { y = __builtin_amdgcn_mfma_f32_32x32x16_bf16(ldsA_perm(Rbp + 32 * s), ub[s], y, 0, 0, 0); y = __builtin_amdgcn_mfma_f32_32x32x16_bf16(ldsA_nat(Rkn + 32 * s), vb[s], y, 0, 0, 0); }
                    const LAS float* lam = (const LAS float*)(L + R_LAM) + cc * 64;
#pragma unroll
                    for (int kt2 = 0; kt2 < 2; ++kt2) {
#pragma unroll
                        for (int q = 0; q < 4; ++q) { const f32x4 l4 = *(const LAS f32x4*)(lam + 32 * kt2 + 8 * q + 4 * hhz);
                            Hacc[kt2][4 * q] *= l4[0]; Hacc[kt2][4 * q + 1] *= l4[1]; Hacc[kt2][4 * q + 2] *= l4[2]; Hacc[kt2][4 * q + 3] *= l4[3]; }
                        const LAS unsigned char* Bhp = L + R_BHT + cc * 5120 + (32 * kt2 + r32z) * 80 + hhz * 8; const LAS unsigned char* Khn = L + R_KHT + cc * 5120 + (32 * kt2 + r32z) * 80 + hhz * 16;
#pragma unroll
                        for (int s = 0; s < 2; ++s) { Hacc[kt2] = __builtin_amdgcn_mfma_f32_32x32x16_bf16(ldsA_perm(Bhp + 32 * s), ub[s], Hacc[kt2], 0, 0, 0);
                            Hacc[kt2] = __builtin_amdgcn_mfma_f32_32x32x16_bf16(ldsA_nat(Khn + 32 * s), vb[s], Hacc[kt2], 0, 0, 0); } }
                    LAS float* yo = (LAS float*)(L + R_YB) + cc * 32 * 64 + wave * 32 + r32z;
#pragma unroll
                    for (int r = 0; r < 16; ++r) yo[crow(r, hhz) * 64] = y[r];
                }
            }
            RK_BAR();
            {
                const LAS float* yp = (const LAS float*)(L + R_YB) + ttz * 64 + 8 * cgz; const LAS float* gp = (const LAS float*)(L + R_GG) + ttz * 64 + 8 * cgz;
                const f32x4 y0 = *(const LAS f32x4*)yp, y1 = *(const LAS f32x4*)(yp + 4), g0 = *(const LAS f32x4*)gp, g1 = *(const LAS f32x4*)(gp + 4);
                const LAS float* cs = (const LAS float*)(L + R_CST) + 512 + 8 * cgz;
                const f32x4 w0_ = *(const LAS f32x4*)(cs), w1_ = *(const LAS f32x4*)(cs + 4), b0_ = *(const LAS f32x4*)(cs + 64), b1_ = *(const LAS f32x4*)(cs + 68);
                const float yv[8] = {y0[0], y0[1], y0[2], y0[3], y1[0], y1[1], y1[2], y1[3]}, gv[8] = {g0[0], g0[1], g0[2], g0[3], g1[0], g1[1], g1[2], g1[3]};
                const float lw[8] = {w0_[0], w0_[1], w0_[2], w0_[3], w1_[0], w1_[1], w1_[2], w1_[3]}, lb[8] = {b0_[0], b0_[1], b0_[2], b0_[3], b1_[0], b1_[1], b1_[2], b1_[3]};
                float sm = 0.f;
#pragma unroll
                for (int j = 0; j < 8; ++j) sm += yv[j];
                const float mean = reduce8(sm) * (1.0f / 64.0f);
                float sv = 0.f;
#pragma unroll
                for (int j = 0; j < 8; ++j) { const float d = yv[j] - mean; sv += d * d; }
                const float rs = rsqrtf(reduce8(sv) * (1.0f / 64.0f) + 64e-5f);
                float o[8];
#pragma unroll
                for (int j = 0; j < 8; ++j) o[j] = ((yv[j] - mean) * rs * lw[j] + lb[j] + bonus * v8[j]) * gv[j];
                ypend = PK8(o);
            }
        }
        *(v4u*)(yr + ((size_t)b * SEQ + (SEQ - RK_T) + tt) * C_YC + ch) = ypend;
#undef RK_PREFETCH
#undef RK_BAR
#undef UNPK8
#undef PK8
        __syncthreads();
    }
    __syncthreads();
}

constexpr int AT_K = 0;
constexpr int AT_V = 55296;
constexpr int AT_LUT = 110592;
constexpr int AT_WS = AT_LUT + 768;
constexpr int AT_OST = AT_WS + 1024;
constexpr int AT_END = AT_OST + 32768;
static_assert(AT_END <= MISC_OFF && (AT_OST % 16) == 0, "attention LDS map");

__device__ __forceinline__ void p3_attn(Frame& F, const Args& A, const int nostore) {
    LAS unsigned char* L = F.lds;
    bf16* patt = (bf16*)(F.ws + WS_PATT);
    float* lse_out = (float*)(F.ws + WS_LSE);
    const float* lutg = (const float*)(F.ws + WS_LUT);
    const int tid = ((int)threadIdx.x), lane = ((int)threadIdx.x & 63), wave = F.wave, r32 = lane & 31, hh = lane >> 5;
#define AT_GEOM(U) const int b = (U) / 96, rem = (U) % 96, hd = rem >> 3, sub = rem & 7, gi = hd >> 2; const int dil = gi == 0 ? 1 : (gi == 1 ? 4 : 16); const size_t tokb = (size_t)b * SEQ; \
        int res, qw, lrow0, kbase; \
        if (gi == 0) { res = 0; kbase = 256 * sub - 128; qw = 256 * sub + 32 * wave; lrow0 = 0; } \
        else if (gi == 1) { res = sub >> 1; kbase = 256 * (sub & 1) - 128; qw = 256 * (sub & 1) + 32 * wave; lrow0 = 0; } \
        else { res = 2 * sub + (wave >> 2); kbase = 0; qw = 32 * (wave & 3); lrow0 = (wave >> 2) * 128; }
#define AT_LOADS(U) do { AT_GEOM(U); (void)lrow0; const int npass_ = gi == 2 ? 4 : 6; \
        _Pragma("unroll") for (int ps = 0; ps < 6; ++ps) { const int lr = ps * 64 + (tid >> 3); int pos, rs_; \
            if (gi == 2) { rs_ = 2 * sub + ((lr >> 7) & 1); pos = lr & 127; } else { rs_ = res; pos = kbase + lr; } \
            kq[ps] = (v4u){0u, 0u, 0u, 0u}; vq[ps] = (v4u){0u, 0u, 0u, 0u}; \
            if (ps < npass_ && pos >= 0) { const bf16* src = patt + (tokb + (size_t)pos * dil + rs_) * C_ATT + hd * 64 + (tid & 7) * 8; kq[ps] = *(const v4u*)(src + 768); vq[ps] = *(const v4u*)(src + 1536); } } \
        } while (0)
#define AT_LOADQ(U) do { AT_GEOM(U); (void)lrow0; (void)kbase; const bf16* qp_ = patt + (tokb + (size_t)(qw + r32) * dil + res) * C_ATT + hd * 64 + hh * 8; \
        _Pragma("unroll") for (int s_ = 0; s_ < 4; ++s_) qv[s_] = *(const v4u*)(qp_ + 16 * s_); } while (0)
    bf16* pend_op = patt; size_t pend_step = 0; float* pend_lp = lse_out; float pend_lse = 0.f; bool pend = false;
#define AT_FLUSH() do { const LAS bf16* stg_ = (const LAS bf16*)(L + AT_OST) + wave * 2048; \
        if (hh == 0 && !nostore) *pend_lp = pend_lse; \
        _Pragma("unroll") for (int i_ = 0; i_ < 4; ++i_) { const v4u v_ = *(const LAS v4u*)(stg_ + (i_ * 8 + (lane >> 3)) * 64 + (lane & 7) * 8); \
            if (!nostore || v_.x == 0x12345678u) *(v4u*)(pend_op + i_ * pend_step) = v_; } } while (0)
    v4u kq[6], vq[6], qv[4];
    if (F.bx < BATCH * 96) { AT_LOADS(F.bx); AT_LOADQ(F.bx); }
    for (int unit = F.bx; unit < BATCH * 96; unit += F.G) {
        AT_GEOM(unit);
        const size_t qtok = tokb + (size_t)(qw + r32) * dil + res;
        const f32x4 kg0 = *(const f32x4*)(A.in[I_KNG] + (tid & 7) * 8), kg1 = *(const f32x4*)(A.in[I_KNG] + (tid & 7) * 8 + 4);
        float lutv = -1e30f; if (tid >= 32 && tid <= 160) lutv = lutg[hd * 132 + tid - 32] * 1.44269504f;
        f32x4 qg0[4], qg1[4];
#pragma unroll
        for (int s = 0; s < 4; ++s) { const float* g = A.in[I_QNG] + 16 * s + 8 * hh; qg0[s] = *(const f32x4*)g; qg1[s] = *(const f32x4*)(g + 4); }
        __syncthreads();
        {
            const int npass = gi == 2 ? 4 : 6;
            const int c8 = tid & 7;
            if (tid < 192) ((LAS float*)(L + AT_LUT))[tid] = lutv;
#pragma unroll
            for (int ps = 0; ps < 6; ++ps) {
                if (ps < npass) {
                    const int lr = ps * 64 + (tid >> 3);
                    float kf[8]; kf[0] = bf_lo(kq[ps].x); kf[1] = bf_hi(kq[ps].x); kf[2] = bf_lo(kq[ps].y); kf[3] = bf_hi(kq[ps].y); kf[4] = bf_lo(kq[ps].z); kf[5] = bf_hi(kq[ps].z); kf[6] = bf_lo(kq[ps].w); kf[7] = bf_hi(kq[ps].w);
                    float ss = 0.f;
#pragma unroll
                    for (int j = 0; j < 8; ++j) ss += kf[j] * kf[j];
                    ss = reduce8(ss);
                    const float rstd = rsqrtf(ss * (1.0f / 64.0f) + 1e-6f);
                    v4u ko; ko.x = cvt_pk_bf16(kf[0] * rstd * kg0[0], kf[1] * rstd * kg0[1]); ko.y = cvt_pk_bf16(kf[2] * rstd * kg0[2], kf[3] * rstd * kg0[3]);
                    ko.z = cvt_pk_bf16(kf[4] * rstd * kg1[0], kf[5] * rstd * kg1[1]); ko.w = cvt_pk_bf16(kf[6] * rstd * kg1[2], kf[7] * rstd * kg1[3]);
                    *(LAS v4u*)(L + AT_K + lr * 144 + c8 * 16) = ko;
                    *(LAS v4u*)(L + AT_V + lr * 144 + c8 * 16) = vq[ps];
                }
            }
        }
        bf16x8 qf[4];
        {
            float ss = 0.f;
#pragma unroll
            for (int s = 0; s < 4; ++s) {
                const float f0 = bf_lo(qv[s].x), f1 = bf_hi(qv[s].x), f2 = bf_lo(qv[s].y), f3 = bf_hi(qv[s].y), f4 = bf_lo(qv[s].z), f5 = bf_hi(qv[s].z), f6 = bf_lo(qv[s].w), f7 = bf_hi(qv[s].w);
                ss += (f0 * f0 + f1 * f1) + (f2 * f2 + f3 * f3) + (f4 * f4 + f5 * f5) + (f6 * f6 + f7 * f7); }
            ss += __shfl_xor(ss, 32);
            const float rstd = rsqrtf(ss * (1.0f / 64.0f) + 1e-6f) * (0.125f * 1.44269504f);
#pragma unroll
            for (int s = 0; s < 4; ++s) { const f32x4 g0 = qg0[s], g1 = qg1[s];
                v4u o; o.x = cvt_pk_bf16(bf_lo(qv[s].x) * rstd * g0[0], bf_hi(qv[s].x) * rstd * g0[1]); o.y = cvt_pk_bf16(bf_lo(qv[s].y) * rstd * g0[2], bf_hi(qv[s].y) * rstd * g0[3]);
                o.z = cvt_pk_bf16(bf_lo(qv[s].z) * rstd * g1[0], bf_hi(qv[s].z) * rstd * g1[1]); o.w = cvt_pk_bf16(bf_lo(qv[s].w) * rstd * g1[2], bf_hi(qv[s].w) * rstd * g1[3]);
                qf[s] = __builtin_bit_cast(bf16x8, o); }
        }
        __syncthreads();
        if (pend) AT_FLUSH();
        const LAS float* lutl = (const LAS float*)(L + AT_LUT) + (r32 - 4 * hh);
        f32x16 p[5]; float m = -1e30f;
#pragma unroll
        for (int jt = 0; jt < 5; ++jt) {
            const int kp0 = qw - 128 + 32 * jt;
            if (kp0 >= 0) {
                const LAS unsigned char* kb = L + AT_K + (lrow0 + kp0 - kbase + r32) * 144 + hh * 16;
                f32x16 c = {};
#pragma unroll
                for (int s = 0; s < 4; ++s) c = __builtin_amdgcn_mfma_f32_32x32x16_bf16(*(const LAS bf16x8*)(kb + s * 32), qf[s], c, 0, 0, 0);
                float bz[16];
#pragma unroll
                for (int r = 0; r < 16; ++r) bz[r] = lutl[160 - 32 * jt - crow(r, 0)];
#pragma unroll
                for (int r = 0; r < 16; ++r) { const float sv = c[r] + bz[r]; c[r] = sv; m = fmaxf(m, sv); }
                p[jt] = c;
            } else {
#pragma unroll
                for (int r = 0; r < 16; ++r) p[jt][r] = -1e30f;
            }
        }
        m = fmaxf(m, __shfl_xor(m, 32));
        float l = 0.f;
#pragma unroll
        for (int jt = 0; jt < 5; ++jt)
#pragma unroll
            for (int r = 0; r < 16; ++r) { const float e = __builtin_amdgcn_exp2f(p[jt][r] - m); p[jt][r] = e; l += e; }
        l += __shfl_xor(l, 32);
        v4u pwk[5][2];
#pragma unroll
        for (int jt = 0; jt < 5; ++jt)
#pragma unroll
            for (int s2 = 0; s2 < 2; ++s2) { pwk[jt][s2].x = cvt_pk_bf16(p[jt][8 * s2 + 0], p[jt][8 * s2 + 1]); pwk[jt][s2].y = cvt_pk_bf16(p[jt][8 * s2 + 2], p[jt][8 * s2 + 3]);
                pwk[jt][s2].z = cvt_pk_bf16(p[jt][8 * s2 + 4], p[jt][8 * s2 + 5]); pwk[jt][s2].w = cvt_pk_bf16(p[jt][8 * s2 + 6], p[jt][8 * s2 + 7]); }
        if (unit + F.G < BATCH * 96) { AT_LOADS(unit + F.G); AT_LOADQ(unit + F.G); }
        f32x16 o[2]; o[0] = (f32x16){}; o[1] = (f32x16){};
#pragma unroll
        for (int jt = 0; jt < 5; ++jt) {
            const int kp0 = qw - 128 + 32 * jt;
            if (kp0 >= 0) {
#pragma unroll
                for (int s2 = 0; s2 < 2; ++s2) {
                    const bf16x8 pa = __builtin_bit_cast(bf16x8, pwk[jt][s2]);
                    const int R0 = lrow0 + kp0 - kbase + 16 * s2 + 4 * hh + ((lane & 15) >> 2);
#pragma unroll
                    for (int db = 0; db < 2; ++db) {
                        const LAS unsigned char* vp = L + AT_V + R0 * 144 + (32 * db + 16 * ((lane >> 4) & 1) + 4 * (lane & 3)) * 2;
                        const v4i16_t lo = __builtin_amdgcn_ds_read_tr16_b64_v4i16((LAS v4i16_t*)vp);
                        const v4i16_t hi = __builtin_amdgcn_ds_read_tr16_b64_v4i16((LAS v4i16_t*)(vp + 8 * 144));
                        const bf16x8 vb = (bf16x8){lo[0], lo[1], lo[2], lo[3], hi[0], hi[1], hi[2], hi[3]};
                        o[db] = __builtin_amdgcn_mfma_f32_32x32x16_bf16(pa, vb, o[db], 0, 0, 0);
                    }
                }
            }
        }
        LAS float* wsf = (LAS float*)(L + AT_WS) + wave * 32;
        if (hh == 0) wsf[r32] = l;
        pend_lse = (m + __log2f(l)) * 0.69314718f; pend_lp = lse_out + qtok * 12 + hd;
        LDS_WAIT(); asm volatile("" ::: "memory");
        LAS bf16* stg = (LAS bf16*)(L + AT_OST) + wave * 2048;
#pragma unroll
        for (int r = 0; r < 16; ++r) { const int orow = crow(r, hh); const float rl = __builtin_amdgcn_rcpf(wsf[orow]);
            const unsigned w0 = cvt_pk_bf16(o[0][r] * rl, 0.f), w1 = cvt_pk_bf16(o[1][r] * rl, 0.f);
            stg[orow * 64 + r32] = (bf16)(w0 & 0xffffu); stg[orow * 64 + 32 + r32] = (bf16)(w1 & 0xffffu); }
        LDS_WAIT(); asm volatile("" ::: "memory");
        pend_op = patt + (tokb + (size_t)(qw + (lane >> 3)) * dil + res) * C_ATT + hd * 64 + (lane & 7) * 8; pend_step = (size_t)8 * dil * C_ATT; pend = true;
    }
    if (pend) AT_FLUSH();
    __syncthreads();
#undef AT_GEOM
#undef AT_LOADS
#undef AT_FLUSH
#undef AT_LOADQ
}

__device__ __forceinline__ void p4_merge(Frame& F) {
    const bf16* og = (const bf16*)(F.ws + WS_PATT); const float* lse = (const float*)(F.ws + WS_LSE); bf16* ya = (bf16*)(F.dout + DO_YR) + 512;
    const size_t step = (size_t)F.G * 512, total = (size_t)NTOK * 32;
    for (size_t i = (size_t)F.bx * 512 + ((int)threadIdx.x); i < total; i += 2 * step) {
        const bool two = (i + step) < total;
        float l[2][3]; v4u x[2][3]; size_t tokv[2]; int cv[2];
#pragma unroll
        for (int u = 0; u < 2; ++u) { const size_t iu = (u == 1 && two) ? i + step : i; const size_t tok = iu >> 5; const int c = (int)(iu & 31), j = c >> 3;
            tokv[u] = tok; cv[u] = c;
            l[u][0] = lse[tok * 12 + j]; l[u][1] = lse[tok * 12 + 4 + j]; l[u][2] = lse[tok * 12 + 8 + j];
            const bf16* p = og + tok * C_ATT + c * 8;
            x[u][0] = *(const v4u*)(p); x[u][1] = *(const v4u*)(p + 256); x[u][2] = *(const v4u*)(p + 512); }
        asm volatile("" ::: "memory");
        v4u o[2];
#pragma unroll
        for (int u = 0; u < 2; ++u) {
            const float mx = fmaxf(l[u][0], fmaxf(l[u][1], l[u][2])); float a0 = __expf(l[u][0] - mx), a1 = __expf(l[u][1] - mx), a2 = __expf(l[u][2] - mx); const float inv = 1.0f / (a0 + a1 + a2); a0 *= inv; a1 *= inv; a2 *= inv;
            const v4u x0 = x[u][0], x1 = x[u][1], x2 = x[u][2];
            o[u].x = cvt_pk_bf16(a0 * bf_lo(x0.x) + a1 * bf_lo(x1.x) + a2 * bf_lo(x2.x), a0 * bf_hi(x0.x) + a1 * bf_hi(x1.x) + a2 * bf_hi(x2.x));
            o[u].y = cvt_pk_bf16(a0 * bf_lo(x0.y) + a1 * bf_lo(x1.y) + a2 * bf_lo(x2.y), a0 * bf_hi(x0.y) + a1 * bf_hi(x1.y) + a2 * bf_hi(x2.y));
            o[u].z = cvt_pk_bf16(a0 * bf_lo(x0.z) + a1 * bf_lo(x1.z) + a2 * bf_lo(x2.z), a0 * bf_hi(x0.z) + a1 * bf_hi(x1.z) + a2 * bf_hi(x2.z));
            o[u].w = cvt_pk_bf16(a0 * bf_lo(x0.w) + a1 * bf_lo(x1.w) + a2 * bf_lo(x2.w), a0 * bf_hi(x0.w) + a1 * bf_hi(x1.w) + a2 * bf_hi(x2.w)); }
        *(v4u*)(ya + tokv[0] * C_YC + cv[0] * 8) = o[0];
        if (two) *(v4u*)(ya + tokv[1] * C_YC + cv[1] * 8) = o[1];
    }
}

constexpr int RT_WH = 0;
constexpr int RT_WL = 66048;
constexpr int RT_CB = 132096;
constexpr int RT_PS = RT_CB + 128;
constexpr int RT_RS = RT_PS + 2048;
constexpr int RT_LCNT = RT_RS + 1024;
constexpr int RT_LBASE = RT_LCNT + 128;
constexpr int RT_REC = RT_LBASE + 128;
static_assert(RT_REC + 4096 <= MISC_OFF, "router LDS map");
__device__ __forceinline__ void p7_route(Frame& F, const Args& A) {
    LAS unsigned char* L = F.lds;
    const float* mod = (const float*)(F.ws + WS_MOD);
    const bf16* x1 = (const bf16*)(F.ws + WS_X1);
    unsigned char* H2 = (unsigned char*)(F.ws + WS_H2);
    float* gates = (float*)(F.ws + WS_GATES); unsigned* tslot = (unsigned*)(F.ws + WS_TSLOT); int* list = (int*)(F.ws + WS_LIST);
    unsigned* gcnt = F.ctl + CW_CNT;
    const int tid = ((int)threadIdx.x), lane = ((int)threadIdx.x & 63), wave = F.wave, r32 = lane & 31, hh = lane >> 5;
    for (int blk = F.bx; blk < NTOK / 256; blk += F.G) {
        const int b = blk >> 3; const float* md = mod + (size_t)b * 6144;
        __syncthreads();
        for (int i0 = tid; i0 < 1024 * 32; i0 += 512 * 8) {
            float rw_[8], ng_[8], sc_[8];
#pragma unroll
            for (int q = 0; q < 8; ++q) { const int i = i0 + 512 * q, k = i >> 5; rw_[q] = A.in[I_RTW][i]; ng_[q] = A.in[I_N2G][k]; sc_[q] = md[4096 + k]; }
            asm volatile("" ::: "memory");
#pragma unroll
            for (int q = 0; q < 8; ++q) { const int i = i0 + 512 * q, k = i >> 5, e = i & 31;
                const float w = rw_[q] * (ng_[q] * (sc_[q] + 1.0f));
                const unsigned hi = cvt_pk_bf16(w, 0.f) & 0xffffu; const float lo = w - __uint_as_float(hi << 16);
                *(LAS bf16*)(L + RT_WH + e * 2064 + k * 2) = (bf16)hi; *(LAS bf16*)(L + RT_WL + e * 2064 + k * 2) = (bf16)(cvt_pk_bf16(lo, 0.f) & 0xffffu); } }
        { const int e = tid & 31, part = tid >> 5; float s = 0.f;
          for (int k0 = part * 64; k0 < part * 64 + 64; k0 += 16) { float a_[16], b_[16];
#pragma unroll
            for (int q = 0; q < 16; ++q) { a_[q] = md[3072 + k0 + q]; b_[q] = A.in[I_RTW][(k0 + q) * 32 + e]; }
            asm volatile("" ::: "memory");
#pragma unroll
            for (int q = 0; q < 16; ++q) s += a_[q] * b_[q]; }
          ((LAS float*)(L + RT_PS))[part * 32 + e] = s; }
        if (tid < 32) ((LAS int*)(L + RT_LCNT))[tid] = 0;
        __syncthreads();
        if (tid < 32) { float s = A.in[I_RTB][tid];
#pragma unroll
            for (int p = 0; p < 16; ++p) s += ((LAS float*)(L + RT_PS))[p * 32 + tid];
            ((LAS float*)(L + RT_CB))[tid] = s; }
        __syncthreads();
        const size_t rbase = (size_t)blk * 256 + wave * 32;
        f32x16 acc = {}; float ss = 0.f;
        {
            const bf16* xp = x1 + (rbase + r32) * D + 8 * hh;
            const LAS unsigned char* wh = L + RT_WH + r32 * 2064 + hh * 16; const LAS unsigned char* wl = L + RT_WL + r32 * 2064 + hh * 16;
            for (int s0 = 0; s0 < 64; s0 += 16) { v4u ab[16];
#pragma unroll
              for (int q = 0; q < 16; ++q) ab[q] = *(const v4u*)(xp + 16 * (s0 + q));
              asm volatile("" ::: "memory");
#pragma unroll
              for (int q = 0; q < 16; ++q) { const int s = s0 + q;
                const v4u a = ab[q];
                const float f0 = bf_lo(a.x), f1 = bf_hi(a.x), f2 = bf_lo(a.y), f3 = bf_hi(a.y), f4 = bf_lo(a.z), f5 = bf_hi(a.z), f6 = bf_lo(a.w), f7 = bf_hi(a.w);
                ss += (f0 * f0 + f1 * f1) + (f2 * f2 + f3 * f3) + (f4 * f4 + f5 * f5) + (f6 * f6 + f7 * f7);
                const bf16x8 af = __builtin_bit_cast(bf16x8, a);
                acc = __builtin_amdgcn_mfma_f32_32x32x16_bf16(af, *(const LAS bf16x8*)(wh + 32 * s), acc, 0, 0, 0);
                acc = __builtin_amdgcn_mfma_f32_32x32x16_bf16(af, *(const LAS bf16x8*)(wl + 32 * s), acc, 0, 0, 0);
              } }
        }
        ss += __shfl_xor(ss, 32);
        const float rstd_own = rsqrtf(ss * (1.0f / D) + 1e-6f);
        LAS float* rs = (LAS float*)(L + RT_RS) + wave * 32;
        if (hh == 0) rs[r32] = rstd_own;
        LDS_WAIT(); asm volatile("" ::: "memory");
        const float cbe = ((const LAS float*)(L + RT_CB))[r32];
#pragma unroll
        for (int r = 0; r < 16; ++r) {
            const int rowl = crow(r, hh);
            float val = acc[r] * rs[rowl] + cbe;
            float tv[4]; int te[4];
#pragma unroll
            for (int kk = 0; kk < 4; ++kk) {
                float mx = val;
#pragma unroll
                for (int o = 1; o < 32; o <<= 1) mx = fmaxf(mx, __shfl_xor(mx, o));
                const unsigned long long bal = __ballot(val == mx);
                const unsigned mymask = hh ? (unsigned)(bal >> 32) : (unsigned)bal;
                te[kk] = __ffs((int)mymask) - 1; tv[kk] = mx;
                if (r32 == te[kk]) val = -3.0e38f;
            }
            const float e1 = __expf(tv[1] - tv[0]), e2 = __expf(tv[2] - tv[0]), e3 = __expf(tv[3] - tv[0]); const float inv = 1.0f / (1.0f + e1 + e2 + e3);
            if (r32 < 4) {
                const int kk = r32; const int e = kk == 0 ? te[0] : (kk == 1 ? te[1] : (kk == 2 ? te[2] : te[3]));
                const float g = (kk == 0 ? 1.0f : (kk == 1 ? e1 : (kk == 2 ? e2 : e3))) * inv;
                const int pos = __hip_atomic_fetch_add((LAS int*)(L + RT_LCNT) + e, 1, __ATOMIC_RELAXED, __HIP_MEMORY_SCOPE_WORKGROUP);
                ((LAS int*)(L + RT_REC))[(wave * 32 + rowl) * 4 + kk] = e | (pos << 8);
                gates[(rbase + rowl) * 4 + kk] = g;
            }
        }
        {
            f32x4 gs[4], sh[4];
#pragma unroll
            for (int j = 0; j < 4; ++j) { const int k = 4 * lane + 256 * j; const f32x4 g = *(const f32x4*)(A.in[I_N2G] + k), sc = *(const f32x4*)(md + 4096 + k); gs[j] = g * (sc + 1.0f); sh[j] = *(const f32x4*)(md + 3072 + k); }
            for (int rr = 0; rr < 32; rr += 8) {
                const size_t row = rbase + rr;
                v2u xv[8][4];
#pragma unroll
                for (int q = 0; q < 8; ++q) { const v2u* xr = (const v2u*)(x1 + (row + q) * D) + lane;
#pragma unroll
                    for (int j = 0; j < 4; ++j) xv[q][j] = xr[64 * j]; }
                asm volatile("" ::: "memory");
                v4u ow[8];
#pragma unroll
                for (int q = 0; q < 8; ++q) { const float rstd = rs[rr + q]; unsigned w4[4];
#pragma unroll
                    for (int j = 0; j < 4; ++j) { const f32x4 v = (f32x4){bf_lo(xv[q][j].x), bf_hi(xv[q][j].x), bf_lo(xv[q][j].y), bf_hi(xv[q][j].y)};
                        const f32x4 y = v * rstd * gs[j] + sh[j]; w4[j] = pk4_fp8(y[0], y[1], y[2], y[3]); }
                    ow[q] = quad_transpose(w4[0], w4[1], w4[2], w4[3], lane); }
#pragma unroll
                for (int q = 0; q < 8; ++q) *(v4u*)(H2 + (row + q) * D + 256 * (lane & 3) + 16 * (lane >> 2)) = ow[q];
            }
        }
        __syncthreads();
        if (tid < 32) ((LAS int*)(L + RT_LBASE))[tid] = (int)atomicAdd(gcnt + tid, (unsigned)((LAS int*)(L + RT_LCNT))[tid]);
        __syncthreads();
        for (int i = tid; i < 1024; i += 512) { const int rec = ((LAS int*)(L + RT_REC))[i]; const int e = rec & 255, slot = ((LAS int*)(L + RT_LBASE))[e] + (rec >> 8);
            const int tok = blk * 256 + (i >> 2);
            list[(size_t)e * CAP + slot] = tok; tslot[(size_t)tok * 4 + (i & 3)] = (unsigned)e | ((unsigned)slot << 8); }
    }
    __syncthreads();
}

constexpr int MO_TPRE = 131072, MO_CNT = MO_TPRE + 256;
__device__ __forceinline__ void moe_tables(Frame& F) {
    __syncthreads();
    if (((int)threadIdx.x) < 64) {
        LAS int* tpre = (LAS int*)(F.lds + MO_TPRE); LAS int* cnt = (LAS int*)(F.lds + MO_CNT); const int ln = (int)threadIdx.x;
        int c = 0;
        if (ln < 32) c = (int)__hip_atomic_load(F.ctl + CW_CNT + ln, __ATOMIC_RELAXED, __HIP_MEMORY_SCOPE_AGENT);
        const int tiles = (c + 255) >> 8; int incl = tiles;
#pragma unroll
        for (int o = 1; o < 32; o <<= 1) { const int v = __shfl_up(incl, o); if (ln >= o) incl += v; }
        if (ln < 32) { cnt[ln] = c; tpre[ln] = incl - tiles; }
        if (ln == 31) tpre[32] = incl;
    }
    __syncthreads();
}
__device__ __forceinline__ void p_combine(Frame& F, const float* b2) {
    const LAS int* tpre = (const LAS int*)(F.lds + MO_TPRE);
    const float* mod = (const float*)(F.ws + WS_MOD); const float* gates = (const float*)(F.ws + WS_GATES); const unsigned* tslot = (const unsigned*)(F.ws + WS_TSLOT);
    const unsigned char* O = (const unsigned char*)(F.ws + WS_OBUF); float* out = (float*)F.dout; const bf16* x1 = (const bf16*)(F.ws + WS_X1);
    const int gw = F.bx * 8 + F.wave, NGW = F.G * 8, lane = (int)threadIdx.x & 63;
    f32x4 gt[2]; v4u ts[2]; gt[0] = gt[1] = (f32x4){0.f, 0.f, 0.f, 0.f}; ts[0] = ts[1] = (v4u){0u, 0u, 0u, 0u};
    if (2 * gw < NTOK) {
#pragma unroll
        for (int u = 0; u < 2; ++u) { gt[u] = *(const f32x4*)(gates + (size_t)(2 * gw + u) * 4); ts[u] = *(const v4u*)(tslot + (size_t)(2 * gw + u) * 4); } }
    f32x4 pra[2][2], prb[2][2]; float* pop = out; bool pend = false;
#pragma unroll
    for (int u = 0; u < 2; ++u) pra[u][0] = pra[u][1] = prb[u][0] = prb[u][1] = (f32x4){0.f, 0.f, 0.f, 0.f};
    for (int t = 2 * gw; t < NTOK; t += 2 * NGW) {
        const size_t tok = (size_t)t; const int b = t >> 11;
        const float* g2 = mod + (size_t)b * 6144 + 5120;
        const unsigned tsv[2][4] = {{ts[0].x, ts[0].y, ts[0].z, ts[0].w}, {ts[1].x, ts[1].y, ts[1].z, ts[1].w}}; const float gv[2][4] = {{gt[0][0], gt[0][1], gt[0][2], gt[0][3]}, {gt[1][0], gt[1][1], gt[1][2], gt[1][3]}};
        v2u ov[2][4][2]; v4u xq[2][2]; f32x4 ga[2], gb[2];
#pragma unroll
        for (int u = 0; u < 2; ++u)
#pragma unroll
            for (int kk = 0; kk < 4; ++kk) { const int e = (int)(tsv[u][kk] & 255u), slot = (int)(tsv[u][kk] >> 8); const unsigned char* orow = O + ((size_t)tpre[e] * 256 + slot) * D + 8 * lane;
                ov[u][kk][0] = *(const v2u*)(orow); ov[u][kk][1] = *(const v2u*)(orow + 512); }
#pragma unroll
        for (int u = 0; u < 2; ++u)
#pragma unroll
            for (int hq = 0; hq < 2; ++hq) xq[u][hq] = *(const v4u*)(x1 + (tok + u) * D + 512 * hq + 8 * lane);
#pragma unroll
        for (int hq = 0; hq < 2; ++hq) { ga[hq] = *(const f32x4*)(g2 + 512 * hq + 8 * lane); gb[hq] = *(const f32x4*)(g2 + 512 * hq + 8 * lane + 4); }
        { const int tn = (t + 2 * NGW < NTOK) ? t + 2 * NGW : t;
#pragma unroll
          for (int u = 0; u < 2; ++u) { gt[u] = *(const f32x4*)(gates + (size_t)(tn + u) * 4); ts[u] = *(const v4u*)(tslot + (size_t)(tn + u) * 4); } }
        asm volatile("" ::: "memory");
        float accv[2][2][8];
#pragma unroll
        for (int u = 0; u < 2; ++u)
#pragma unroll
        for (int hq = 0; hq < 2; ++hq) {
#pragma unroll
            for (int j = 0; j < 8; ++j) accv[u][hq][j] = 0.f;
#pragma unroll
            for (int kk = 0; kk < 4; ++kk) { const v2u v = ov[u][kk][hq]; const float g = gv[u][kk];
                const f32x2 p0 = __builtin_amdgcn_cvt_pk_f32_fp8((int)v.x, false), p1 = __builtin_amdgcn_cvt_pk_f32_fp8((int)v.x, true), p2 = __builtin_amdgcn_cvt_pk_f32_fp8((int)v.y, false), p3 = __builtin_amdgcn_cvt_pk_f32_fp8((int)v.y, true);
                accv[u][hq][0] += g * p0[0]; accv[u][hq][1] += g * p0[1]; accv[u][hq][2] += g * p1[0]; accv[u][hq][3] += g * p1[1];
                accv[u][hq][4] += g * p2[0]; accv[u][hq][5] += g * p2[1]; accv[u][hq][6] += g * p3[0]; accv[u][hq][7] += g * p3[1]; } }
        asm volatile("" : "+v"(gt[0]), "+v"(gt[1]), "+v"(ts[0]), "+v"(ts[1]));
        if (pend) {
#pragma unroll
            for (int u = 0; u < 2; ++u) { float* po = pop + (size_t)u * D; *(f32x4*)(po) = pra[u][0]; *(f32x4*)(po + 4) = prb[u][0]; *(f32x4*)(po + 512) = pra[u][1]; *(f32x4*)(po + 516) = prb[u][1]; } }
#pragma unroll
        for (int u = 0; u < 2; ++u)
#pragma unroll
        for (int hq = 0; hq < 2; ++hq) {
            const v4u xv = xq[u][hq];
            const f32x4 xa = (f32x4){bf_lo(xv.x), bf_hi(xv.x), bf_lo(xv.y), bf_hi(xv.y)}, xb = (f32x4){bf_lo(xv.z), bf_hi(xv.z), bf_lo(xv.w), bf_hi(xv.w)};
            f32x4 ra, rb; ra[0] = xa[0] + ga[hq][0] * accv[u][hq][0]; ra[1] = xa[1] + ga[hq][1] * accv[u][hq][1]; ra[2] = xa[2] + ga[hq][2] * accv[u][hq][2]; ra[3] = xa[3] + ga[hq][3] * accv[u][hq][3];
            rb[0] = xb[0] + gb[hq][0] * accv[u][hq][4]; rb[1] = xb[1] + gb[hq][1] * accv[u][hq][5]; rb[2] = xb[2] + gb[hq][2] * accv[u][hq][6]; rb[3] = xb[3] + gb[hq][3] * accv[u][hq][7];
            pra[u][hq] = ra; prb[u][hq] = rb; }
        pop = out + tok * D + 8 * lane; pend = true;
    }
    if (pend) {
#pragma unroll
        for (int u = 0; u < 2; ++u) { float* po = pop + (size_t)u * D; *(f32x4*)(po) = pra[u][0]; *(f32x4*)(po + 4) = prb[u][0]; *(f32x4*)(po + 512) = pra[u][1]; *(f32x4*)(po + 516) = prb[u][1]; } }
}

constexpr int N_PHASES = 11;
__global__ void __launch_bounds__(512, 2) hybrid_fwd(Args args) {
    extern __shared__ __attribute__((aligned(16))) unsigned char lds_raw[];
    Frame F;
    F.lds = (LAS unsigned char*)lds_raw; F.MISC = (volatile LAS unsigned*)(F.lds + MISC_OFF);
    F.wave = __builtin_amdgcn_readfirstlane(((int)threadIdx.x) >> 6);
    F.G = gridDim.x; F.bx = blockIdx.x; F.ws = args.ws; F.dout = (unsigned char*)args.out; F.ctl = (unsigned*)(args.ws + WS_CTL);
    if (((int)threadIdx.x) < 128) ((LAS unsigned*)(F.lds + MISC_OFF))[((int)threadIdx.x)] = 0u;
    __syncthreads();
    XcdBarrier bar; bar.bar = F.ctl + CW_BAR; bar.x = 0; bar.st = nullptr;
    const int lo = args.ph_lo, hi = args.ph_hi;
    if (hi - lo > 1) bar = xcd_barrier_post(F.ctl + CW_BAR, F.MISC + 8);
#ifndef PH_MASK
#define PH_MASK 0xffffffffu
#endif
#define IN(k) (((PH_MASK >> (k)) & 1u) && lo <= (k) && (k) < hi)
#define SEAM(k) do { if (IN(k) && IN((k) + 1)) xcd_barrier(bar); } while (0)
    unsigned char* ws = args.ws;

    if (IN(0)) {
#pragma unroll 1
        for (int rep = 0; rep < NREP(0); ++rep) p0_prologue(F, args); } SEAM(0);
    if (IN(1)) {
#pragma unroll 1
        for (int rep = 0; rep < NREP(1); ++rep) p1_norm(F, args); } SEAM(1);
    if (IN(2)) {
#pragma unroll 1
        for (int rep = 0; rep < NREP(2); ++rep) {
        pg8::DenseOrder S; S.init(F.dout + DO_H, ws + WS_WEXT, NTOK, NEXT, D, F.G, F.bx); S.rb = D;
        pg8::EpiProj E{(bf16*)(ws + WS_PRKV), (bf16*)(ws + WS_PATT), (unsigned char*)(ws + WS_PGATE), (bf16*)(F.dout + DO_PLORA)};
        pg8::gemm_phase<pg8::EpiProj, pg8::DenseOrder, false, true>(F.lds, S, E); }
    } SEAM(2);
    if (IN(3)) {
#pragma unroll 1
        for (int rep = 0; rep < NREP(3); ++rep) p3_rwkv(F, args);
#pragma unroll 1
        for (int rep = 0; rep < NREP(16); ++rep) p3_attn(F, args, rep); } SEAM(3);
    if (IN(4)) {
#pragma unroll 1
        for (int rep = 0; rep < NREP(4); ++rep) p4_merge(F); } SEAM(4);
    if (IN(5)) {
#pragma unroll 1
      for (int rep = 0; rep < NREP(5); ++rep) {
        { pg8::SegOrder S; S.init(F.dout + DO_YR, ws + WS_WBRR, NTOK, D, F.G, F.bx);
          pg8::EpiMixF E{(bf16*)(ws + WS_MIXED), (const unsigned char*)(ws + WS_PGATE)};
          pg8::gemm_phase<pg8::EpiMixF, pg8::SegOrder, false>(F.lds, S, E); }
      }
    } SEAM(5);
    if (IN(6)) {
#pragma unroll 1
      for (int rep = 0; rep < NREP(6); ++rep) {
        pg8::DenseOrder S; S.init(ws + WS_MIXED, ws + WS_WOUT, NTOK, D, D, F.G, F.bx);
        pg8::EpiOut E{args.in[I_X], (bf16*)(ws + WS_X1), (const float*)(ws + WS_MOD)};
        pg8::gemm_phase<pg8::EpiOut, pg8::DenseOrder, false>(F.lds, S, E); }
    } SEAM(6);
    if (IN(7)) { p7_route(F, args); } SEAM(7);
    if (IN(8)) {
#pragma unroll 1
        for (int rep = 0; rep < NREP(8); ++rep) { moe_tables(F);
        pg8::MoeOrder S; S.A = (const char*)(ws + WS_H2); S.Bt = (const char*)(ws + WS_W1T); S.K = D; S.rb = D; S.ncol = 8; S.G = F.G; S.c = F.bx; S.bstride = (size_t)2048 * 1024;
        S.tpre = (const LAS int*)(F.lds + MO_TPRE); S.cnt = (const LAS int*)(F.lds + MO_CNT); S.list = (const int*)(ws + WS_LIST); S.nunits = S.tpre[32] * 8;
        pg8::EpiSwiglu E{(unsigned char*)(ws + WS_ACT), (const float*)(ws + WS_B1P)};
        pg8::gemm_phase<pg8::EpiSwiglu, pg8::MoeOrder, true, true>(F.lds, S, E); } } SEAM(8);
    if (IN(9)) {
#pragma unroll 1
        for (int rep = 0; rep < NREP(9); ++rep) { moe_tables(F);
        pg8::MoeOrder S; S.A = (const char*)(ws + WS_ACT); S.Bt = (const char*)(ws + WS_W2E); S.K = D; S.rb = D; S.ncol = 4; S.G = F.G; S.c = F.bx; S.bstride = (size_t)1024 * 1024;
        S.tpre = (const LAS int*)(F.lds + MO_TPRE); S.cnt = (const LAS int*)(F.lds + MO_CNT); S.list = nullptr; S.nunits = S.tpre[32] * 4;
        pg8::EpiDown E{(unsigned char*)(ws + WS_OBUF), args.in[I_EB2]};
        pg8::gemm_phase<pg8::EpiDown, pg8::MoeOrder, false, true>(F.lds, S, E); } } SEAM(9);
    if (IN(10)) { moe_tables(F); p_combine(F, args.in[I_EB2]); }
#undef IN
#undef SEAM
}

extern "C" void kernel_launch(void* const* d_in, const int* in_sizes, int n_in, void* d_out, int out_size, void* d_ws, size_t ws_size, hipStream_t stream) {
    static int grid = 0;
    if (grid == 0) {
        if (n_in != 34 || out_size != NTOK * D || ws_size < WS_END) { fprintf(stderr, "kernel_launch: unexpected shapes (n_in %d, out %d, ws %zu)\n", n_in, out_size, ws_size); grid = -1; return; }
        int dev = 0, cus = 0, per_cu = 0;
        if (hipGetDevice(&dev) != hipSuccess || hipDeviceGetAttribute(&cus, hipDeviceAttributeMultiprocessorCount, dev) != hipSuccess) { grid = -1; return; }
        if (hipFuncSetAttribute((const void*)hybrid_fwd, hipFuncAttributeMaxDynamicSharedMemorySize, LDS_BYTES) != hipSuccess) { fprintf(stderr, "kernel_launch: hipFuncSetAttribute failed\n"); grid = -1; return; }
        if (hipOccupancyMaxActiveBlocksPerMultiprocessor(&per_cu, (const void*)hybrid_fwd, 512, LDS_BYTES) != hipSuccess || per_cu < 1) fprintf(stderr, "kernel_launch: occupancy query says %d\n", per_cu);
        (void)hipGetLastError();
        grid = cus;
    }
    if (grid < 0) return;
    (void)hipMemsetAsync((char*)d_ws + WS_CTL, 0, CTL_ZERO_BYTES, stream);
    Args a{};
    for (int i = 0; i < 34; ++i) a.in[i] = (const float*)d_in[i];
    a.out = (float*)d_out; a.ws = (unsigned char*)d_ws;
#if MK_N_LAUNCHES == 1
    a.ph_lo = 0; a.ph_hi = N_PHASES;
    hipLaunchKernelGGL(hybrid_fwd, dim3(grid), dim3(512), LDS_BYTES, stream, a);
#else
    for (int p = 0; p < N_PHASES; ++p) { a.ph_lo = p; a.ph_hi = p + 1; hipLaunchKernelGGL(hybrid_fwd, dim3(grid), dim3(512), LDS_BYTES, stream, a); }
#endif
}
```
